# Optimizing an MI355X kernel written in HIP

```python
import jax, jax.numpy as jnp
from jax import lax
import numpy as np

D_MODEL = 1024
BATCH = 1
SEQ = 16384
DEPTH = 1

POOL_WIDTH = D_MODEL // 2
POOL_WINDOWS = (2, 4, 8, 16)
N_POOL_GROUPS = len(POOL_WINDOWS)
POOL_GROUP = POOL_WIDTH // N_POOL_GROUPS
HEAD_DIM = 64
N_HEADS = (D_MODEL - POOL_WIDTH) // HEAD_DIM
N_KV = 2
GQA_GROUP = N_HEADS // N_KV
KV_WIDTH = N_KV * HEAD_DIM
N_BRANCH = 3
CMP_LEN = 32
CMP_STRIDE = 16
CMP_HIDDEN = 4 * HEAD_DIM
SEL_BLOCK = 64
N_SEL = 16
WINDOW = 512
Q_BLOCK = 128
MIX_WIDTH = POOL_WIDTH + N_HEADS * HEAD_DIM
IN_WIDTH = POOL_WIDTH + N_HEADS * HEAD_DIM + 6 * KV_WIDTH + N_BRANCH * N_HEADS
D_FF = 4 * D_MODEL
NEG_INF = -1e30
FORCE_BONUS = 1e4
EPS = 1e-6

kernel_name = "hybrid_pool_nsa_adaln_block"


def rms_norm(x, g):
    xf = x.astype(jnp.float32)
    y = xf * lax.rsqrt(jnp.mean(xf * xf, axis=-1, keepdims=True) + EPS)
    return (y * g.astype(jnp.float32)).astype(x.dtype)


def alibi_slopes(n):
    return jnp.asarray([2.0 ** (-8.0 * (h + 1) / n) for h in range(n)], jnp.float32)


def causal_multiscale_pool(u, w_pool, pool_scale):
    B, S, _ = u.shape
    ug = u.reshape(B, S, N_POOL_GROUPS, POOL_GROUP)
    cs = jnp.cumsum(ug.astype(jnp.float32), axis=1)
    cs = jnp.concatenate([jnp.zeros_like(cs[:, :1]), cs], axis=1)
    t = jnp.arange(S)
    means = []
    for gi, w in enumerate(POOL_WINDOWS):
        lo = jnp.maximum(t + 1 - w, 0)
        win_sum = cs[:, t + 1, gi] - cs[:, lo, gi]
        cnt = (t + 1 - lo).astype(jnp.float32)[None, :, None]
        means.append(win_sum / cnt)
    pooled = jnp.stack(means, axis=2).astype(u.dtype) - ug
    y = jnp.einsum('bsgc,gcd->bsgd', pooled, w_pool)
    return y.reshape(B, S, POOL_WIDTH) * pool_scale


def compress_blocks(kv, pos_emb, w1, b1, w2, b2):
    B, S = kv.shape[0], kv.shape[1]
    n_cmp = (S - CMP_LEN) // CMP_STRIDE + 1
    idx = jnp.arange(n_cmp)[:, None] * CMP_STRIDE + jnp.arange(CMP_LEN)[None, :]
    blocks = kv[:, idx] + pos_emb[:, None, :]
    flat = blocks.transpose(0, 1, 3, 2, 4).reshape(B, n_cmp, N_KV, CMP_LEN * HEAD_DIM)
    hid = jax.nn.gelu(flat @ w1 + b1)
    return hid @ w2 + b2


def nsa_attention(q, k_cmp, v_cmp, k_sel, v_sel, k_win, v_win, gates):
    B, S = q.shape[0], q.shape[1]
    n_cmp = k_cmp.shape[1]
    n_blk = S // SEL_BLOCK
    n_top = min(N_SEL, n_blk)
    n_qb = S // Q_BLOCK
    scale = HEAD_DIM ** -0.5
    slopes_gr = alibi_slopes(N_HEADS).reshape(N_KV, GQA_GROUP)

    cmp_start = jnp.arange(n_cmp) * CMP_STRIDE
    cmp_end = cmp_start + CMP_LEN - 1
    sel_start = jnp.arange(n_blk) * SEL_BLOCK
    overlap = jnp.clip(jnp.minimum(cmp_start[:, None] + CMP_LEN, sel_start[None, :] + SEL_BLOCK)
                       - jnp.maximum(cmp_start[:, None], sel_start[None, :]), 0, None)
    overlap = (overlap / CMP_LEN).astype(jnp.float32)

    qg = q.reshape(B, S, N_KV, GQA_GROUP, HEAD_DIM)
    gg = gates.reshape(B, S, N_KV, GQA_GROUP, N_BRANCH)
    k_sel_b = k_sel.reshape(B, n_blk, SEL_BLOCK, N_KV, HEAD_DIM).transpose(0, 3, 1, 2, 4)
    v_sel_b = v_sel.reshape(B, n_blk, SEL_BLOCK, N_KV, HEAD_DIM).transpose(0, 3, 1, 2, 4)
    pad = jnp.zeros((B, WINDOW, N_KV, HEAD_DIM), k_win.dtype)
    k_win_p = jnp.concatenate([pad, k_win], axis=1)
    v_win_p = jnp.concatenate([pad.astype(v_win.dtype), v_win], axis=1)
    b_ix = jnp.arange(B)[:, None, None, None]
    g_ix = jnp.arange(N_KV)[None, :, None, None]
    blk = jnp.arange(n_blk)

    def block_fn(qb):
        q0 = qb * Q_BLOCK
        t = q0 + jnp.arange(Q_BLOCK)
        qblk = lax.dynamic_slice_in_dim(qg, q0, Q_BLOCK, axis=1)
        gblk = lax.dynamic_slice_in_dim(gg, q0, Q_BLOCK, axis=1)

        d_c = (t[:, None] - cmp_end[None, :]).astype(jnp.float32)
        ok_c = d_c >= 0
        s_c = (jnp.einsum('btgrd,bngd->bgrtn', qblk, k_cmp, preferred_element_type=jnp.float32) * scale
               - slopes_gr[:, :, None, None] * d_c)
        s_c = jnp.where(ok_c, s_c, NEG_INF)
        p_c = jnp.where(ok_c, jax.nn.softmax(s_c, axis=-1), 0.0)
        o_c = jnp.einsum('bgrtn,bngd->btgrd', p_c.astype(v_cmp.dtype), v_cmp)

        imp = jnp.einsum('bgrtn,nj->bgtj', p_c, overlap)
        cur = t // SEL_BLOCK
        causal = blk[None, :] <= cur[:, None]
        forced = (blk[None, :] == 0) | (blk[None, :] == cur[:, None]) | (blk[None, :] == cur[:, None] - 1)
        imp = jnp.where(causal, imp + FORCE_BONUS * forced, -1.0)
        top_val, top_idx = lax.top_k(imp, n_top)
        ok_blk = top_val >= 0

        k_g = k_sel_b[b_ix, g_ix, top_idx]
        v_g = v_sel_b[b_ix, g_ix, top_idx]
        pos = top_idx[..., None] * SEL_BLOCK + jnp.arange(SEL_BLOCK)
        d_s = (t[None, None, :, None, None] - pos).astype(jnp.float32)
        ok_s = (d_s >= 0) & ok_blk[..., None]
        s_s = (jnp.einsum('btgrd,bgtnld->bgrtnl', qblk, k_g, preferred_element_type=jnp.float32) * scale
               - slopes_gr[None, :, :, None, None, None] * d_s[:, :, None])
        s_s = jnp.where(ok_s[:, :, None], s_s, NEG_INF)
        p_s = jax.nn.softmax(s_s.reshape(B, N_KV, GQA_GROUP, Q_BLOCK, n_top * SEL_BLOCK), axis=-1)
        p_s = p_s.reshape(s_s.shape)
        o_s = jnp.einsum('bgrtnl,bgtnld->btgrd', p_s.astype(v_g.dtype), v_g)

        k_w = lax.dynamic_slice_in_dim(k_win_p, q0, Q_BLOCK + WINDOW, axis=1)
        v_w = lax.dynamic_slice_in_dim(v_win_p, q0, Q_BLOCK + WINDOW, axis=1)
        src = q0 - WINDOW + jnp.arange(Q_BLOCK + WINDOW)
        d_w = t[:, None] - src[None, :]
        ok_w = (d_w >= 0) & (d_w < WINDOW) & (src[None, :] >= 0)
        s_w = (jnp.einsum('btgrd,bkgd->bgrtk', qblk, k_w, preferred_element_type=jnp.float32) * scale
               - slopes_gr[:, :, None, None] * d_w.astype(jnp.float32))
        s_w = jnp.where(ok_w, s_w, NEG_INF)
        p_w = jax.nn.softmax(s_w, axis=-1)
        o_w = jnp.einsum('bgrtk,bkgd->btgrd', p_w.astype(v_w.dtype), v_w)

        return gblk[..., 0:1] * o_c + gblk[..., 1:2] * o_s + gblk[..., 2:3] * o_w

    out = lax.map(block_fn, jnp.arange(n_qb))
    return out.transpose(1, 0, 2, 3, 4, 5).reshape(B, S, N_HEADS * HEAD_DIM)


def hybrid_mixer(h, w_in, w_pool, pool_scale, q_gain, kc_gain, ks_gain, kw_gain, cmp_k, cmp_v, w_out):
    B, S, _ = h.shape
    proj = h @ w_in
    splits = list(np.cumsum([POOL_WIDTH, N_HEADS * HEAD_DIM] + [KV_WIDTH] * 6))
    u, q, kc, vc, ksl, vsl, kw, vw, g = jnp.split(proj, splits, axis=-1)
    kv4 = lambda a: a.reshape(B, S, N_KV, HEAD_DIM)
    q = rms_norm(q.reshape(B, S, N_HEADS, HEAD_DIM), q_gain)
    k_cmp = rms_norm(compress_blocks(kv4(kc), *cmp_k), kc_gain)
    v_cmp = compress_blocks(kv4(vc), *cmp_v)
    k_sel = rms_norm(kv4(ksl), ks_gain)
    k_win = rms_norm(kv4(kw), kw_gain)
    gates = jax.nn.sigmoid(g.reshape(B, S, N_HEADS, N_BRANCH))
    pool_out = causal_multiscale_pool(u, w_pool, pool_scale)
    attn_out = nsa_attention(q, k_cmp, v_cmp, k_sel, kv4(vsl), k_win, kv4(vw), gates)
    return jnp.concatenate([pool_out, attn_out], axis=-1) @ w_out


def setup_inputs(seed: int = 0) -> dict:
    key = jax.random.key(seed)
    ks = jax.random.split(key, 26)
    L = DEPTH
    f32 = jnp.float32
    nrm = lambda k, shape, fan_in: jax.random.normal(k, shape, f32) * fan_in ** -0.5
    gain = lambda k, shape: 1.0 + 0.02 * jax.random.normal(k, shape, f32)
    small = lambda k, shape, s: s * jax.random.normal(k, shape, f32)
    return {
        "x": jax.random.normal(ks[0], (BATCH, SEQ, D_MODEL), f32),
        "c": jax.random.normal(ks[1], (BATCH, D_MODEL), f32),
        "w_ada": 0.5 * nrm(ks[2], (L, D_MODEL, 6 * D_MODEL), D_MODEL),
        "b_ada": small(ks[3], (L, 6 * D_MODEL), 0.01),
        "norm1_g": gain(ks[4], (L, D_MODEL)),
        "norm2_g": gain(ks[5], (L, D_MODEL)),
        "w_in": nrm(ks[6], (L, D_MODEL, IN_WIDTH), D_MODEL),
        "w_pool": nrm(ks[7], (L, N_POOL_GROUPS, POOL_GROUP, POOL_GROUP), POOL_GROUP),
        "pool_scale": gain(ks[8], (L, POOL_WIDTH)),
        "q_gain": gain(ks[9], (L, HEAD_DIM)),
        "kc_gain": gain(ks[10], (L, HEAD_DIM)),
        "ks_gain": gain(ks[11], (L, HEAD_DIM)),
        "kw_gain": gain(ks[12], (L, HEAD_DIM)),
        "cmp_pos_k": small(ks[13], (L, CMP_LEN, HEAD_DIM), 0.1),
        "cmp_w1_k": nrm(ks[14], (L, CMP_LEN * HEAD_DIM, CMP_HIDDEN), CMP_LEN * HEAD_DIM),
        "cmp_b1_k": small(ks[15], (L, CMP_HIDDEN), 0.01),
        "cmp_w2_k": nrm(ks[16], (L, CMP_HIDDEN, HEAD_DIM), CMP_HIDDEN),
        "cmp_b2_k": small(ks[17], (L, HEAD_DIM), 0.01),
        "cmp_pos_v": small(ks[18], (L, CMP_LEN, HEAD_DIM), 0.1),
        "cmp_w1_v": nrm(ks[19], (L, CMP_LEN * HEAD_DIM, CMP_HIDDEN), CMP_LEN * HEAD_DIM),
        "cmp_b1_v": small(ks[20], (L, CMP_HIDDEN), 0.01),
        "cmp_w2_v": nrm(ks[21], (L, CMP_HIDDEN, HEAD_DIM), CMP_HIDDEN),
        "cmp_b2_v": small(ks[22], (L, HEAD_DIM), 0.01),
        "w_out": nrm(ks[23], (L, MIX_WIDTH, D_MODEL), MIX_WIDTH),
        "w_ff1": nrm(ks[24], (L, D_MODEL, D_FF), D_MODEL),
        "w_ff2": nrm(ks[25], (L, D_FF, D_MODEL), D_FF),
    }


def reference(x, c, w_ada, b_ada, norm1_g, norm2_g, w_in, w_pool, pool_scale, q_gain, kc_gain,
              ks_gain, kw_gain, cmp_pos_k, cmp_w1_k, cmp_b1_k, cmp_w2_k, cmp_b2_k, cmp_pos_v,
              cmp_w1_v, cmp_b1_v, cmp_w2_v, cmp_b2_v, w_out, w_ff1, w_ff2):
    for l in range(DEPTH):
        mod = c @ w_ada[l] + b_ada[l]
        sh1, sc1, ga1, sh2, sc2, ga2 = [m[:, None, :] for m in jnp.split(mod, 6, axis=-1)]
        h = rms_norm(x, norm1_g[l]) * (1.0 + sc1) + sh1
        cmp_k = (cmp_pos_k[l], cmp_w1_k[l], cmp_b1_k[l], cmp_w2_k[l], cmp_b2_k[l])
        cmp_v = (cmp_pos_v[l], cmp_w1_v[l], cmp_b1_v[l], cmp_w2_v[l], cmp_b2_v[l])
        x = x + ga1 * hybrid_mixer(h, w_in[l], w_pool[l], pool_scale[l], q_gain[l], kc_gain[l],
                                   ks_gain[l], kw_gain[l], cmp_k, cmp_v, w_out[l])
        h = rms_norm(x, norm2_g[l]) * (1.0 + sc2) + sh2
        x = x + ga2 * (jnp.square(jax.nn.relu(h @ w_ff1[l])) @ w_ff2[l])
    return x
```

```cpp
#include <hip/hip_runtime.h>
#include <hip/hip_cooperative_groups.h>
#include <cstdio>
#include <cstdint>
namespace cg = cooperative_groups;
namespace pg8 {
#define PG8_LAS __attribute__((address_space(3)))
typedef unsigned short bf16_t;
typedef short bf16x8 __attribute__((ext_vector_type(8)));
typedef float f32x4 __attribute__((ext_vector_type(4)));
typedef unsigned u32x4 __attribute__((ext_vector_type(4)));
constexpr int BM = 256, BK = 64, HALF = 128, HTB = HALF * BK * 2  , STAGE_BYTES = 8 * HTB, NXCD = 8, WGM = 8;

__host__ __device__ __forceinline__ int lds_byte(int r, int c) { const int st = (r >> 4) * 2 + (c >> 5), rr = r & 15, cc = c & 31, ob = rr * 64 + cc * 2; return st * 1024 + (ob ^ (((ob >> 9) & 1) << 5)); }
__host__ __device__ __forceinline__ void stage_rc(int b, int& R, int& C) { const int st = b / 1024, sb = b % 1024, swz = sb ^ (((sb >> 9) & 1) << 5); R = (st >> 1) * 16 + swz / 64; C = (st & 1) * 32 + (swz % 64) / 2; }
__host__ __device__ __forceinline__ int perm32(int rho) { const int n = rho >> 4, i = rho & 15; return 8 * (i >> 2) + 4 * n + (i & 3); }

struct Unit { int pm, pn; };
struct Gemm { const bf16_t* A; const bf16_t* Bt; int M, N, K; };

struct StaticOrder {
    int nM, nN, nwg, G, c;
    __host__ __device__ void init(int M, int N, int G_, int c_) { nM = M / BM; nN = N / BM; nwg = nM * nN; G = G_; c = c_; }
    __host__ __device__ bool next(int i, Unit& u) const {
        const long L = (long)i * G + c; if (L >= nwg) return false;
        int wgid = (int)L; { const int q = nwg / NXCD, r = nwg % NXCD, xcd = wgid % NXCD, off = wgid / NXCD; wgid = (xcd < r ? xcd * (q + 1) : r * (q + 1) + (xcd - r) * q) + off; }
        const int nig = WGM * nN, gid = wgid / nig, fm = gid * WGM, gsz = (nM - fm) < WGM ? (nM - fm) : WGM;
        u.pm = fm + ((wgid % nig) % gsz); u.pn = (wgid % nig) / gsz; return true;
    }
    __device__ __forceinline__ void a_ready(const Unit&) const {}
    __device__ __forceinline__ void done(const Unit&) const {}
};

__device__ __forceinline__ unsigned cvt_pk_bf16(float lo, float hi) { unsigned r; asm volatile("v_cvt_pk_bf16_f32 %0, %1, %2" : "=v"(r) : "v"(lo), "v"(hi)); return r; }
template <class Epi, class Sched, bool ALIGN_EPI = false, bool SP2 = false>
__device__ __forceinline__ void gemm_phase(PG8_LAS unsigned char* lds, const Gemm g, const Sched& S, const Epi& E) {
    const int tid = threadIdx.x, wid = __builtin_amdgcn_readfirstlane(tid >> 6), lane = tid & 63, wr = wid >> 2, wc = wid & 3, fr = lane & 15, fq = lane >> 4;
    const int K = g.K, nt = K / BK;
    unsigned voffA[2], voffB[2];
#pragma unroll
    for (int i = 0; i < 2; ++i) { int R, C; stage_rc(tid * 16 + i * 8192, R, C); const int Rb = Epi::PERM ? ((R & ~31) + perm32(R & 31)) : R;
        voffA[i] = (unsigned)(R * K + C) * 2u; voffB[i] = (unsigned)(Rb * K + C) * 2u; }
    const size_t kstep = (size_t)(BK * 2);
    const size_t hstep = (size_t)HALF * K * 2;
    const size_t tstep = 2 * hstep;
    const unsigned ldsw = (unsigned)wid * 1024u;
    const int aoff = lds_byte(wr * 64 + fr, fq * 8), boff = lds_byte(wc * 32 + fr, fq * 8);
#define PG8_SA(b, h) (((b) * 2 + (h)) * HTB)
#define PG8_SB(b, h) ((4 + (b) * 2 + (h)) * HTB)
#define PG8_STAGE(bufoff, gbase, voff) do { _Pragma("unroll") for (int _i = 0; _i < 2; ++_i) \
        __builtin_amdgcn_global_load_lds((const unsigned*)((const char*)(gbase) + (voff)[_i]), (PG8_LAS unsigned*)(lds + (bufoff) + ldsw + _i * 8192), 16, 0, 0); } while (0)
#define PG8_LDA(dst, b, h) do { _Pragma("unroll") for (int m = 0; m < 4; ++m) _Pragma("unroll") for (int k = 0; k < 2; ++k) dst[m][k] = *(const PG8_LAS bf16x8*)(lds + PG8_SA(b, h) + aoff + m * 2048 + k * 1024); } while (0)
#define PG8_LDB(dst, b, h) do { _Pragma("unroll") for (int n = 0; n < 2; ++n) _Pragma("unroll") for (int k = 0; k < 2; ++k) dst[n][k] = *(const PG8_LAS bf16x8*)(lds + PG8_SB(b, h) + boff + n * 2048 + k * 1024); } while (0)
#define PG8_MMA(ai, bj, At, Bt) do { __builtin_amdgcn_s_setprio(1); _Pragma("unroll") for (int m = 0; m < 4; ++m) _Pragma("unroll") for (int n = 0; n < 2; ++n) _Pragma("unroll") for (int k = 0; k < 2; ++k) \
        acc[ai][bj][m][n] = __builtin_amdgcn_mfma_f32_16x16x32_bf16(Bt[n][k], At[m][k], acc[ai][bj][m][n], 0, 0, 0); __builtin_amdgcn_s_setprio(0); } while (0)
#define PG8_WAIT_V(n) asm volatile("s_waitcnt vmcnt(" #n ")" ::: "memory")
#define PG8_WAIT_L(n) asm volatile("s_waitcnt lgkmcnt(" #n ")" ::: "memory")
#define PG8_BAR __builtin_amdgcn_s_barrier()
#define PG8_SCHED __builtin_amdgcn_sched_barrier(0)
    Unit cur, nxt; int ui = 0;
    if (!S.next(0, cur)) return;
    f32x4 acc[2][2][4][2];
#pragma unroll
    for (int a = 0; a < 2; ++a)
#pragma unroll
        for (int b = 0; b < 2; ++b)
#pragma unroll
            for (int m = 0; m < 4; ++m)
#pragma unroll
                for (int n = 0; n < 2; ++n) acc[a][b][m][n] = (f32x4){0.f, 0.f, 0.f, 0.f};
    bf16x8 At[4][2], B0[2][2], B1[2][2];
    const char* cA = (const char*)g.A + (size_t)cur.pm * tstep; const char* cB = (const char*)g.Bt + (size_t)cur.pn * tstep;
    S.a_ready(cur);
    if constexpr (SP2) {
        PG8_STAGE(PG8_SB(0, 0), cB, voffB); PG8_STAGE(PG8_SB(0, 1), cB + hstep, voffB); PG8_STAGE(PG8_SA(0, 0), cA, voffA); PG8_STAGE(PG8_SA(0, 1), cA + hstep, voffA);
        if (wr == 1) PG8_BAR;
        PG8_WAIT_V(2); PG8_BAR;
        PG8_STAGE(PG8_SB(1, 0), cB + kstep, voffB); PG8_STAGE(PG8_SA(1, 0), cA + kstep, voffA); PG8_STAGE(PG8_SB(1, 1), cB + hstep + kstep, voffB);
        PG8_WAIT_V(6); PG8_BAR;
    } else {
        PG8_STAGE(PG8_SB(0, 0), cB, voffB); PG8_STAGE(PG8_SA(0, 0), cA, voffA); PG8_STAGE(PG8_SB(0, 1), cB + hstep, voffB); PG8_STAGE(PG8_SA(0, 1), cA + hstep, voffA);
        if (wr == 1) PG8_BAR;
        PG8_WAIT_V(4); PG8_BAR;
        PG8_STAGE(PG8_SB(1, 0), cB + kstep, voffB); PG8_STAGE(PG8_SA(1, 0), cA + kstep, voffA); PG8_STAGE(PG8_SB(1, 1), cB + hstep + kstep, voffB);
        PG8_WAIT_V(6); PG8_BAR;
    }
    for (;;) {
        const bool has_next = S.next(ui + 1, nxt);
        const char* nA = has_next ? (const char*)g.A + (size_t)nxt.pm * tstep : cA; const char* nB = has_next ? (const char*)g.Bt + (size_t)nxt.pn * tstep : cB;
        for (int t = 0; t < nt; t += 2) {
            const bool last = (t == nt - 2);
            const char* a1 = cA + (size_t)(t + 1) * kstep;
            const char* a2 = last ? nA : cA + (size_t)(t + 2) * kstep; const char* b2 = last ? nB : cB + (size_t)(t + 2) * kstep;
            const char* a3 = a2 + kstep; const char* b3 = b2 + kstep;
            if (last && has_next) S.a_ready(nxt);
            if constexpr (SP2) {
            PG8_LDB(B0, 0, 0); PG8_LDB(B1, 0, 1); PG8_SCHED; PG8_LDA(At, 0, 0); PG8_STAGE(PG8_SA(1, 1), a1 + hstep, voffA);
            PG8_WAIT_V(8); PG8_WAIT_L(0); PG8_BAR; PG8_MMA(0, 0, At, B0); PG8_MMA(0, 1, At, B1); PG8_BAR; PG8_SCHED;
            PG8_LDA(At, 0, 1); PG8_STAGE(PG8_SB(0, 0), b2, voffB); PG8_STAGE(PG8_SB(0, 1), b2 + hstep, voffB); PG8_STAGE(PG8_SA(0, 0), a2, voffA);
            PG8_WAIT_V(8); PG8_WAIT_L(0); PG8_BAR; PG8_MMA(1, 0, At, B0); PG8_MMA(1, 1, At, B1); PG8_BAR; PG8_SCHED;
            PG8_LDB(B0, 1, 0); PG8_LDB(B1, 1, 1); PG8_SCHED; PG8_LDA(At, 1, 0); PG8_STAGE(PG8_SA(0, 1), a2 + hstep, voffA);
            PG8_WAIT_V(8); PG8_WAIT_L(0); PG8_BAR; PG8_MMA(0, 0, At, B0); PG8_MMA(0, 1, At, B1); PG8_BAR; PG8_SCHED;
            PG8_LDA(At, 1, 1); PG8_STAGE(PG8_SB(1, 0), b3, voffB); PG8_STAGE(PG8_SB(1, 1), b3 + hstep, voffB); PG8_STAGE(PG8_SA(1, 0), a3, voffA);
            PG8_WAIT_V(8); PG8_WAIT_L(0); PG8_BAR; PG8_MMA(1, 0, At, B0); PG8_MMA(1, 1, At, B1); PG8_BAR; PG8_SCHED;
            } else {
            PG8_LDB(B0, 0, 0); PG8_SCHED; PG8_LDA(At, 0, 0); PG8_STAGE(PG8_SA(1, 1), a1 + hstep, voffA);
            PG8_WAIT_L(8); PG8_BAR; PG8_WAIT_L(0); PG8_MMA(0, 0, At, B0); PG8_BAR; PG8_SCHED;
            PG8_LDB(B1, 0, 1); PG8_STAGE(PG8_SB(0, 0), b2, voffB);
            PG8_BAR; PG8_WAIT_L(0); PG8_MMA(0, 1, At, B1); PG8_BAR;
            PG8_LDA(At, 0, 1); PG8_STAGE(PG8_SA(0, 0), a2, voffA);
            PG8_BAR; PG8_WAIT_L(0); PG8_MMA(1, 0, At, B0); PG8_BAR; PG8_SCHED;
            PG8_STAGE(PG8_SB(0, 1), b2 + hstep, voffB);
            PG8_WAIT_V(6); PG8_BAR; PG8_MMA(1, 1, At, B1); PG8_BAR;
            PG8_LDB(B0, 1, 0); PG8_SCHED; PG8_LDA(At, 1, 0); PG8_STAGE(PG8_SA(0, 1), a2 + hstep, voffA);
            PG8_WAIT_L(8); PG8_BAR; PG8_WAIT_L(0); PG8_MMA(0, 0, At, B0); PG8_BAR; PG8_SCHED;
            PG8_LDB(B1, 1, 1); PG8_STAGE(PG8_SB(1, 0), b3, voffB);
            PG8_BAR; PG8_WAIT_L(0); PG8_MMA(0, 1, At, B1); PG8_BAR;
            PG8_LDA(At, 1, 1); PG8_STAGE(PG8_SA(1, 0), a3, voffA);
            PG8_BAR; PG8_WAIT_L(0); PG8_MMA(1, 0, At, B0); PG8_BAR; PG8_SCHED;
            PG8_STAGE(PG8_SB(1, 1), b3 + hstep, voffB);
            PG8_WAIT_V(6); PG8_BAR; PG8_MMA(1, 1, At, B1); PG8_BAR;
            }
        }
        if constexpr (ALIGN_EPI) { if (wr == 0) PG8_BAR; }
        if constexpr (!Epi::AFTER_DRAIN) { E(acc, cur, wr, wc, fr, fq); S.done(cur); }
        if (!has_next) break;
#pragma unroll
        for (int a = 0; a < 2; ++a)
#pragma unroll
            for (int b = 0; b < 2; ++b)
#pragma unroll
                for (int m = 0; m < 4; ++m)
#pragma unroll
                    for (int n = 0; n < 2; ++n) acc[a][b][m][n] = (f32x4){0.f, 0.f, 0.f, 0.f};
        cur = nxt; cA = nA; cB = nB; ++ui;
        if constexpr (ALIGN_EPI) { if (wr == 1) PG8_BAR; }
    }
    PG8_WAIT_V(0);
    if constexpr (!ALIGN_EPI) { if (wr == 0) PG8_BAR; }
    PG8_BAR;
    if constexpr (Epi::AFTER_DRAIN) { E.fused(acc, cur, wr, wc, fr, fq, lds, wid, lane); S.done(cur); }
#undef PG8_SA
#undef PG8_SB
#undef PG8_STAGE
#undef PG8_LDA
#undef PG8_LDB
#undef PG8_MMA
#undef PG8_WAIT_V
#undef PG8_WAIT_L
#undef PG8_BAR
#undef PG8_SCHED
}
}

using pg8::bf16_t; using pg8::bf16x8; using pg8::f32x4; using pg8::u32x4;
#define LAS __attribute__((address_space(3)))
#define DI __device__ __forceinline__
#define LDS_WAIT() asm volatile("s_waitcnt lgkmcnt(0)" ::: "memory")
typedef unsigned u32x2 __attribute__((ext_vector_type(2)));

constexpr int SEQ = 16384, DM = 1024, NIN = 2048, INW = 1816, FF = 4096;
constexpr float EPS = 1e-6f;
constexpr float LOG2E = 1.4426950408889634f;
constexpr float C2 = 0.125f * LOG2E;
constexpr size_t MiB = 1u << 20;
constexpr size_t WS_MOD = 1 * MiB;
constexpr size_t WS_BIASIN = WS_MOD + 32768;
constexpr size_t WS_BIASFF = WS_BIASIN + 8192;
constexpr size_t WS_BIASC = WS_BIASFF + 16384;
constexpr size_t WS_RSTD1 = WS_BIASC + 2048;
constexpr size_t WS_RSS2 = WS_RSTD1 + 65536;
constexpr size_t WS_G = 2 * MiB;
constexpr size_t WS_KCMP = 4 * MiB;
constexpr size_t WS_VCMPT = 4 * MiB + 262144;
constexpr size_t WS_WINT = 5 * MiB;
constexpr size_t WS_WOUTT = 9 * MiB;
constexpr size_t WS_WFF1T = 11 * MiB;
constexpr size_t WS_WFF2T = 19 * MiB;
constexpr size_t WS_W1CT = 27 * MiB;
constexpr size_t WS_PCMP = 29 * MiB;
constexpr size_t WS_XB = 40 * MiB;
constexpr size_t WS_H = 72 * MiB;
constexpr size_t WS_U = 72 * MiB;
constexpr size_t WS_Q = 88 * MiB;
constexpr size_t WS_ACMP = 104 * MiB;
constexpr size_t WS_KS = 112 * MiB;
constexpr size_t WS_KW = 116 * MiB;
constexpr size_t WS_VST = 120 * MiB;
constexpr size_t WS_VWT = 124 * MiB;
constexpr size_t WS_A2 = 128 * MiB;
constexpr size_t WS_END = 200 * MiB;
constexpr int LDS_BYTES = 147456;
constexpr int XCH_OFF = 131072;
constexpr int WAVE_LDS = 17408;

struct Params {
    const float* in[26];
    float* out;
    unsigned char* ws;
    int ph_lo, ph_hi;
};
enum { I_X = 0, I_C, I_WADA, I_BADA, I_N1G, I_N2G, I_WIN, I_WPOOL, I_PSCALE, I_QG, I_KCG, I_KSG, I_KWG,
       I_POSK, I_W1K, I_B1K, I_W2K, I_B2K, I_POSV, I_W1V, I_B1V, I_W2V, I_B2V, I_WOUT, I_WFF1, I_WFF2 };

DI unsigned pk2(float lo, float hi) { return pg8::cvt_pk_bf16(lo, hi); }
DI float bf2f(unsigned short h) { return __uint_as_float((unsigned)h << 16); }
DI float wave_sum(float v) {
#pragma unroll
    for (int o = 1; o < 64; o <<= 1) v += __shfl_xor(v, o);
    return v;
}
DI float wave_max(float v) {
#pragma unroll
    for (int o = 1; o < 64; o <<= 1) v = fmaxf(v, __shfl_xor(v, o));
    return v;
}

DI void gemv_item(const float* v, const float* W, int ldw, int K, int j0, int nvalid, const float* bias, float* out, LAS float* red, int tid) {
    const int c = tid & 31, kp = tid >> 5, j = j0 + c;
    float s = 0.f;
    if (j < nvalid) {
#pragma unroll 8
        for (int k = kp; k < K; k += 16) s += v[k] * W[(size_t)k * ldw + j];
    }
    red[kp * 32 + c] = s;
    __syncthreads();
    if (tid < 32) {
        float t = 0.f;
#pragma unroll
        for (int i = 0; i < 16; ++i) t += red[i * 32 + tid];
        if (j0 + tid < nvalid) out[j0 + tid] = t + (bias ? bias[j0 + tid] : 0.f);
    }
    __syncthreads();
}

DI void transpose_item(const float* W, int ldw, int k0, int n0, int nvalid, const float* sg, const float* sm, bf16_t* WT, int ldt, int row_off, int col_off, LAS float* scr, int lane) {
#pragma unroll 8
    for (int i = 0; i < 32; ++i) {
        const int kk = 2 * i + (lane >> 5), n = n0 + (lane & 31);
        float v = (n < nvalid) ? W[(size_t)(k0 + kk) * ldw + n] : 0.f;
        if (sg) v *= sg[k0 + kk] * (1.f + sm[k0 + kk]);
        scr[kk * 33 + (lane & 31)] = v;
    }
    LDS_WAIT();
    const int c = lane & 7;
#pragma unroll
    for (int j = 0; j < 4; ++j) {
        const int n = (lane >> 3) + 8 * j; const LAS float* s = scr + (8 * c) * 33 + n;
        u32x4 o; o.x = pk2(s[0 * 33], s[1 * 33]); o.y = pk2(s[2 * 33], s[3 * 33]); o.z = pk2(s[4 * 33], s[5 * 33]); o.w = pk2(s[6 * 33], s[7 * 33]);
        *(u32x4*)(WT + (size_t)(row_off + n0 + n) * ldt + col_off + k0 + 8 * c) = o;
    }
    LDS_WAIT();
}

DI void phase0(const Params& p, LAS unsigned char* lds, int tid, int lane, int wave, int G) {
    unsigned char* ws = p.ws;
    float* mod = (float*)(ws + WS_MOD);
    LAS float* red = (LAS float*)(lds + XCH_OFF);
    for (int it = blockIdx.x; it < 192 + 16; it += G) {
        if (it < 192) gemv_item(p.in[I_C], p.in[I_WADA], 6 * DM, DM, it * 32, 6 * DM, p.in[I_BADA], mod, red, tid);
        else { const int r = it - 192, kv = r >> 3, j0 = (r & 7) * 32;
            gemv_item(p.in[kv ? I_POSV : I_POSK], p.in[kv ? I_W1V : I_W1K], 256, 2048, j0, 256, p.in[kv ? I_B1V : I_B1K], (float*)(ws + WS_BIASC) + kv * 256, red, tid); }
    }
    LAS float* scr = (LAS float*)(lds + wave * 16384);
    const int gw = blockIdx.x * 8 + wave, NGW = G * 8;
    constexpr int N_ROWS = SEQ, N_TO = 8 * 32, N_T2 = 64 * 32, N_TC = 4 * 128, N_WC = 512, N_Z1 = 512, N_Z2 = 64;
    constexpr int NITEMS = N_ROWS + N_TO + N_T2 + N_TC + N_WC + N_Z1 + N_Z2;
    for (int it = gw; it < NITEMS; it += NGW) {
        int r = it;
        if (r < N_ROWS) {
            const f32x4* xr = (const f32x4*)(p.in[I_X] + (size_t)r * DM) + lane;
            f32x4 v[4]; float s = 0.f;
#pragma unroll
            for (int j = 0; j < 4; ++j) { v[j] = xr[64 * j]; s += (v[j].x * v[j].x + v[j].y * v[j].y) + (v[j].z * v[j].z + v[j].w * v[j].w); }
            s = wave_sum(s);
            if (lane == 0) ((float*)(ws + WS_RSTD1))[r] = rsqrtf(s * (1.f / DM) + EPS);
            u32x2* o8 = (u32x2*)((bf16_t*)(ws + WS_XB) + (size_t)r * DM) + lane;
#pragma unroll
            for (int j = 0; j < 4; ++j) { u32x2 o; o.x = pk2(v[j].x, v[j].y); o.y = pk2(v[j].z, v[j].w); o8[64 * j] = o; }
            continue;
        }
        r -= N_ROWS;
        if (r < N_TO) {
            transpose_item(p.in[I_WOUT] + (size_t)512 * DM, DM, (r >> 5) * 64, (r & 31) * 32, DM, nullptr, nullptr, (bf16_t*)(ws + WS_WOUTT), DM, 0, 512, scr, lane);
            continue;
        }
        r -= N_TO;
        if (r < N_T2) {
            transpose_item(p.in[I_WFF2], DM, (r >> 5) * 64, (r & 31) * 32, DM, nullptr, nullptr, (bf16_t*)(ws + WS_WFF2T), FF, 0, 0, scr, lane);
            continue;
        }
        r -= N_T2;
        if (r < N_TC) {
            const int piece = r >> 7, q = r & 127, kv = piece >> 1, half = piece & 1;
            transpose_item(p.in[kv ? I_W1V : I_W1K] + (size_t)half * 1024 * 256, 256, (q >> 3) * 64, (q & 7) * 32, 256, nullptr, nullptr, (bf16_t*)(ws + WS_W1CT), 1024, piece * 256, 0, scr, lane);
            continue;
        }
        r -= N_TC;
        if (r < N_WC) {
            const int g = r >> 7, nt = (r >> 3) & 15, cc = r & 7, n = nt * 64 + lane;
            const float* wp = p.in[I_WPOOL] + (size_t)(g * 128 + cc * 16) * 128;
            const float* ps = p.in[I_PSCALE] + g * 128;
            const float* wo = p.in[I_WOUT] + (size_t)(g * 128) * DM + n;
            float acc[16];
#pragma unroll
            for (int i = 0; i < 16; ++i) acc[i] = 0.f;
            for (int d = 0; d < 128; ++d) {
                const float z = ps[d] * wo[(size_t)d * DM];
#pragma unroll
                for (int i = 0; i < 16; ++i) acc[i] += wp[i * 128 + d] * z;
            }
            u32x4 o0, o1;
            o0.x = pk2(acc[0], acc[1]); o0.y = pk2(acc[2], acc[3]); o0.z = pk2(acc[4], acc[5]); o0.w = pk2(acc[6], acc[7]);
            o1.x = pk2(acc[8], acc[9]); o1.y = pk2(acc[10], acc[11]); o1.z = pk2(acc[12], acc[13]); o1.w = pk2(acc[14], acc[15]);
            bf16_t* dst = (bf16_t*)(ws + WS_WOUTT) + (size_t)n * DM + g * 128 + cc * 16;
            *(u32x4*)dst = o0; *(u32x4*)(dst + 8) = o1;
            continue;
        }
        r -= N_WC;
        if (r < N_Z1) { u32x4 z = {0u, 0u, 0u, 0u}; *((u32x4*)(ws + WS_KCMP) + (size_t)r * 64 + lane) = z; continue; }
        r -= N_Z1;
        { u32x4 z = {0u, 0u, 0u, 0u}; *((u32x4*)(ws + WS_RSS2) + (size_t)r * 64 + lane) = z; }
    }
}

DI void phase1(const Params& p, LAS unsigned char* lds, int tid, int lane, int wave, int G) {
    unsigned char* ws = p.ws;
    const float* mod = (const float*)(ws + WS_MOD);
    LAS float* red = (LAS float*)(lds + XCH_OFF);
    for (int it = blockIdx.x; it < 57 + 128; it += G) {
        if (it < 57) gemv_item(mod + 0, p.in[I_WIN], INW, DM, it * 32, INW, nullptr, (float*)(ws + WS_BIASIN), red, tid);
        else gemv_item(mod + 3 * DM, p.in[I_WFF1], FF, DM, (it - 57) * 32, FF, nullptr, (float*)(ws + WS_BIASFF), red, tid);
    }
    LAS float* scr = (LAS float*)(lds + wave * 16384);
    const int gw = blockIdx.x * 8 + wave, NGW = G * 8;
    constexpr int N_TI = 16 * 57, N_T1 = 16 * 128;
    for (int it = gw; it < N_TI + N_T1; it += NGW) {
        if (it < N_TI) transpose_item(p.in[I_WIN], INW, (it / 57) * 64, (it % 57) * 32, INW, p.in[I_N1G], mod + 1 * DM, (bf16_t*)(ws + WS_WINT), DM, 0, 0, scr, lane);
        else { const int r = it - N_TI; transpose_item(p.in[I_WFF1], FF, (r >> 7) * 64, (r & 127) * 32, FF, p.in[I_N2G], mod + 4 * DM, (bf16_t*)(ws + WS_WFF1T), DM, 0, 0, scr, lane); }
    }
}

DI u32x4 pack8(const f32x4& a, const f32x4& b) { u32x4 w; w.x = pk2(a[0], a[1]); w.y = pk2(a[2], a[3]); w.z = pk2(b[0], b[1]); w.w = pk2(b[2], b[3]); return w; }

struct EpiIn {
    static constexpr bool PERM = true, AFTER_DRAIN = false;
    const float* rstd1; const float* bias; const float* q_gain; const float* ks_gain; const float* kw_gain;
    bf16_t *U, *Q, *ACMP, *KS, *KW, *VST, *VWT; float* G; LAS float* xch;
    DI void operator()(const f32x4 (&acc)[2][2][4][2], const pg8::Unit& u, int wr, int wc, int fr, int fq) const {
        const int pn = u.pn, row0 = u.pm * 256 + wr * 64 + fr, wid = wr * 4 + wc;
        const int colb = pn * 256 + wc * 32 + 8 * fq;
        const int gsel = wc >> 1, d0 = (wc & 1) * 32 + 8 * fq;
#pragma unroll
        for (int bj = 0; bj < 2; ++bj) {
            float ss[2][4];
#pragma unroll
            for (int ai = 0; ai < 2; ++ai)
#pragma unroll
                for (int m = 0; m < 4; ++m) {
                    const float rsv = rstd1[row0 + ai * 128 + m * 16];
                    const f32x4 v0 = acc[ai][bj][m][0] * rsv + *(const f32x4*)(bias + colb + bj * 128), v1 = acc[ai][bj][m][1] * rsv + *(const f32x4*)(bias + colb + bj * 128 + 4);
                    float s = (v0[0] * v0[0] + v0[1] * v0[1]) + (v0[2] * v0[2] + v0[3] * v0[3]) + (v1[0] * v1[0] + v1[1] * v1[1]) + (v1[2] * v1[2] + v1[3] * v1[3]);
                    s += __shfl_xor(s, 16); s += __shfl_xor(s, 32);
                    ss[ai][m] = s;
                }
            if (fq == 0) {
#pragma unroll
                for (int ai = 0; ai < 2; ++ai)
#pragma unroll
                    for (int m = 0; m < 4; ++m) xch[wid * 256 + ((bj * 2 + ai) * 4 + m) * 16 + fr] = ss[ai][m];
            }
            LDS_WAIT(); __builtin_amdgcn_s_barrier(); asm volatile("" ::: "memory");
#pragma unroll
            for (int ai = 0; ai < 2; ++ai)
#pragma unroll
                for (int m = 0; m < 4; ++m) ss[ai][m] += xch[(wid ^ 1) * 256 + ((bj * 2 + ai) * 4 + m) * 16 + fr];
#pragma unroll
            for (int ai = 0; ai < 2; ++ai)
#pragma unroll
                for (int m = 0; m < 4; ++m) {
                    const int row = row0 + ai * 128 + m * 16;
                    const float rsv = rstd1[row];
                    f32x4 v0 = acc[ai][bj][m][0] * rsv + *(const f32x4*)(bias + colb + bj * 128), v1 = acc[ai][bj][m][1] * rsv + *(const f32x4*)(bias + colb + bj * 128 + 4);
                    if (pn < 2) {
                        *(u32x4*)(U + (size_t)row * 512 + pn * 256 + bj * 128 + wc * 32 + 8 * fq) = pack8(v0, v1);
                    } else if (pn < 4) {
                        const float rn = rsqrtf(ss[ai][m] * (1.f / 64.f) + EPS);
                        const f32x4 g0 = *(const f32x4*)(q_gain + d0), g1 = *(const f32x4*)(q_gain + d0 + 4);
                        v0 = v0 * rn * g0; v1 = v1 * rn * g1;
                        *(u32x4*)(Q + (size_t)row * 512 + (pn - 2) * 256 + bj * 128 + wc * 32 + 8 * fq) = pack8(v0, v1);
                    } else if (pn == 4) {
                        *(u32x4*)(ACMP + ((size_t)(bj * 2 + gsel) * SEQ + row) * 64 + d0) = pack8(v0, v1);
                    } else if (pn < 7) {
                        if (bj == 0) {
                            const float* gain = (pn == 5) ? ks_gain : kw_gain;
                            const float rn = rsqrtf(ss[ai][m] * (1.f / 64.f) + EPS);
                            const f32x4 g0 = *(const f32x4*)(gain + d0), g1 = *(const f32x4*)(gain + d0 + 4);
                            v0 = v0 * rn * g0; v1 = v1 * rn * g1;
                            bf16_t* K = (pn == 5) ? KS : KW;
                            *(u32x4*)(K + ((size_t)gsel * SEQ + row) * 64 + d0) = pack8(v0, v1);
                        } else {
                            bf16_t* VT = ((pn == 5) ? VST : VWT) + (((size_t)gsel * 512 + (row >> 5)) * 64 + d0) * 32 + (row & 31);
                            const u32x4 w = pack8(v0, v1);
                            VT[0 * 32] = (bf16_t)(w.x & 0xffffu); VT[1 * 32] = (bf16_t)(w.x >> 16); VT[2 * 32] = (bf16_t)(w.y & 0xffffu); VT[3 * 32] = (bf16_t)(w.y >> 16);
                            VT[4 * 32] = (bf16_t)(w.z & 0xffffu); VT[5 * 32] = (bf16_t)(w.z >> 16); VT[6 * 32] = (bf16_t)(w.w & 0xffffu); VT[7 * 32] = (bf16_t)(w.w >> 16);
                        }
                    } else {
                        if (bj == 0 && wc == 0 && fq < 3) {
                            f32x4 s0, s1;
#pragma unroll
                            for (int i = 0; i < 4; ++i) { s0[i] = 1.f / (1.f + __expf(-v0[i])); s1[i] = 1.f / (1.f + __expf(-v1[i])); }
                            *(f32x4*)(G + (size_t)row * 24 + 8 * fq) = s0; *(f32x4*)(G + (size_t)row * 24 + 8 * fq + 4) = s1;
                        }
                    }
                }
        }
    }
};

struct EpiCmp {
    static constexpr bool PERM = true, AFTER_DRAIN = false;
    float* P;
    DI void operator()(const f32x4 (&acc)[2][2][4][2], const pg8::Unit& u, int wr, int wc, int fr, int fq) const {
        const int row0 = u.pm * 256 + wr * 64 + fr, col0 = (u.pn & 1) * 256 + wc * 32 + 8 * fq;
#pragma unroll
        for (int ai = 0; ai < 2; ++ai)
#pragma unroll
            for (int m = 0; m < 4; ++m)
#pragma unroll
                for (int bj = 0; bj < 2; ++bj) {
                    float* dst = P + (size_t)(row0 + ai * 128 + m * 16) * 512 + col0 + bj * 128;
                    *(f32x4*)dst = acc[ai][bj][m][0]; *(f32x4*)(dst + 4) = acc[ai][bj][m][1];
                }
    }
};
struct CmpOrder {
    int G, c;
    DI bool next(int i, pg8::Unit& u) const { const long L = (long)i * G + c; if (L >= 32) return false; u.pm = (int)(L >> 1); u.pn = (int)(L & 1) + 2 * (u.pm >> 3); return true; }
    DI void a_ready(const pg8::Unit&) const {}
    DI void done(const pg8::Unit&) const {}
};

struct EpiOut {
    static constexpr bool PERM = true, AFTER_DRAIN = false;
    const float* x; const float* ga1; float* out; bf16_t* X1b; float* rss2;
    DI void operator()(const f32x4 (&acc)[2][2][4][2], const pg8::Unit& u, int wr, int wc, int fr, int fq) const {
        const int row0 = u.pm * 256 + wr * 64 + fr, col0 = u.pn * 256 + wc * 32 + 8 * fq;
        f32x4 gv[2][2];
#pragma unroll
        for (int bj = 0; bj < 2; ++bj)
#pragma unroll
            for (int n = 0; n < 2; ++n) gv[bj][n] = *(const f32x4*)(ga1 + col0 + bj * 128 + 4 * n);
#pragma unroll
        for (int ai = 0; ai < 2; ++ai)
#pragma unroll
            for (int m = 0; m < 4; ++m) {
                const int row = row0 + ai * 128 + m * 16; float s = 0.f;
#pragma unroll
                for (int bj = 0; bj < 2; ++bj) {
                    const size_t off = (size_t)row * DM + col0 + bj * 128;
                    const f32x4 x0 = *(const f32x4*)(x + off), x1 = *(const f32x4*)(x + off + 4);
                    const f32x4 v0 = x0 + gv[bj][0] * acc[ai][bj][m][0], v1 = x1 + gv[bj][1] * acc[ai][bj][m][1];
                    *(f32x4*)(out + off) = v0; *(f32x4*)(out + off + 4) = v1;
                    *(u32x4*)(X1b + off) = pack8(v0, v1);
                    s += (v0[0] * v0[0] + v0[1] * v0[1]) + (v0[2] * v0[2] + v0[3] * v0[3]) + (v1[0] * v1[0] + v1[1] * v1[1]) + (v1[2] * v1[2] + v1[3] * v1[3]);
                }
                s += __shfl_xor(s, 16); s += __shfl_xor(s, 32);
                if (fq == 0) atomicAdd(rss2 + row, s);
            }
    }
};

struct EpiFF1 {
    static constexpr bool PERM = true, AFTER_DRAIN = false;
    const float* rss2; const float* bias; bf16_t* H;
    DI void operator()(const f32x4 (&acc)[2][2][4][2], const pg8::Unit& u, int wr, int wc, int fr, int fq) const {
        const int row0 = u.pm * 256 + wr * 64 + fr, col0 = u.pn * 256 + wc * 32 + 8 * fq;
        f32x4 bv[2][2];
#pragma unroll
        for (int bj = 0; bj < 2; ++bj)
#pragma unroll
            for (int n = 0; n < 2; ++n) bv[bj][n] = *(const f32x4*)(bias + col0 + bj * 128 + 4 * n);
#pragma unroll
        for (int ai = 0; ai < 2; ++ai)
#pragma unroll
            for (int m = 0; m < 4; ++m) {
                const int row = row0 + ai * 128 + m * 16;
                const float rs = rsqrtf(rss2[row] * (1.f / DM) + EPS);
#pragma unroll
                for (int bj = 0; bj < 2; ++bj) {
                    f32x4 v0 = acc[ai][bj][m][0] * rs + bv[bj][0], v1 = acc[ai][bj][m][1] * rs + bv[bj][1];
#pragma unroll
                    for (int i = 0; i < 4; ++i) { const float a = fmaxf(v0[i], 0.f), b = fmaxf(v1[i], 0.f); v0[i] = a * a; v1[i] = b * b; }
                    *(u32x4*)(H + (size_t)row * FF + col0 + bj * 128) = pack8(v0, v1);
                }
            }
    }
};

struct EpiFF2 {
    static constexpr bool PERM = true, AFTER_DRAIN = false;
    const float* ga2; float* out;
    DI void operator()(const f32x4 (&acc)[2][2][4][2], const pg8::Unit& u, int wr, int wc, int fr, int fq) const {
        const int row0 = u.pm * 256 + wr * 64 + fr, col0 = u.pn * 256 + wc * 32 + 8 * fq;
        f32x4 gv[2][2];
#pragma unroll
        for (int bj = 0; bj < 2; ++bj)
#pragma unroll
            for (int n = 0; n < 2; ++n) gv[bj][n] = *(const f32x4*)(ga2 + col0 + bj * 128 + 4 * n);
#pragma unroll
        for (int ai = 0; ai < 2; ++ai)
#pragma unroll
            for (int m = 0; m < 4; ++m)
#pragma unroll
                for (int bj = 0; bj < 2; ++bj) {
                    float* dst = out + (size_t)(row0 + ai * 128 + m * 16) * DM + col0 + bj * 128;
                    const f32x4 x0 = *(const f32x4*)dst, x1 = *(const f32x4*)(dst + 4);
                    *(f32x4*)dst = x0 + gv[bj][0] * acc[ai][bj][m][0]; *(f32x4*)(dst + 4) = x1 + gv[bj][1] * acc[ai][bj][m][1];
                }
    }
};

DI void pooled_phase(const Params& p, int tid, int G) {
    const bf16_t* U = (const bf16_t*)(p.ws + WS_U);
    bf16_t* A2 = (bf16_t*)(p.ws + WS_A2);
    const int nb = G - 32;
    for (int idx = (blockIdx.x - 32) * 512 + tid; idx < SEQ * 64; idx += nb * 512) {
        const int t = idx >> 6, c8 = idx & 63, gi = c8 >> 4, w = 2 << gi;
        const int lo = (t + 1 - w) > 0 ? (t + 1 - w) : 0;
        float s[8];
#pragma unroll
        for (int i = 0; i < 8; ++i) s[i] = 0.f;
        for (int tt = lo; tt <= t; ++tt) {
            const u32x4 v = *(const u32x4*)(U + (size_t)tt * 512 + c8 * 8);
            s[0] += __uint_as_float(v.x << 16); s[1] += __uint_as_float(v.x & 0xffff0000u); s[2] += __uint_as_float(v.y << 16); s[3] += __uint_as_float(v.y & 0xffff0000u);
            s[4] += __uint_as_float(v.z << 16); s[5] += __uint_as_float(v.z & 0xffff0000u); s[6] += __uint_as_float(v.w << 16); s[7] += __uint_as_float(v.w & 0xffff0000u);
        }
        const float inv = 1.f / (float)(t + 1 - lo);
        const u32x4 v = *(const u32x4*)(U + (size_t)t * 512 + c8 * 8);
        float r[8];
        r[0] = s[0] * inv - __uint_as_float(v.x << 16); r[1] = s[1] * inv - __uint_as_float(v.x & 0xffff0000u);
        r[2] = s[2] * inv - __uint_as_float(v.y << 16); r[3] = s[3] * inv - __uint_as_float(v.y & 0xffff0000u);
        r[4] = s[4] * inv - __uint_as_float(v.z << 16); r[5] = s[5] * inv - __uint_as_float(v.z & 0xffff0000u);
        r[6] = s[6] * inv - __uint_as_float(v.w << 16); r[7] = s[7] * inv - __uint_as_float(v.w & 0xffff0000u);
        u32x4 o; o.x = pk2(r[0], r[1]); o.y = pk2(r[2], r[3]); o.z = pk2(r[4], r[5]); o.w = pk2(r[6], r[7]);
        *(u32x4*)(A2 + (size_t)t * DM + c8 * 8) = o;
    }
}

DI void phase4(const Params& p, LAS unsigned char* lds, int lane, int wave, int G) {
    unsigned char* ws = p.ws;
    const float* P = (const float*)(ws + WS_PCMP);
    const float* biasc = (const float*)(ws + WS_BIASC);
    LAS float* hb = (LAS float*)(lds + wave * 1024);
    const int gw = blockIdx.x * 8 + wave, NGW = G * 8;
    for (int r = gw; r < 4 * 1023; r += NGW) {
        const int kvg = r / 1023, n = r - kvg * 1023, kv = kvg >> 1, g = kvg & 1;
        const float* p0 = P + (size_t)(kvg * 1024 + n) * 512;
#pragma unroll
        for (int i = 0; i < 4; ++i) {
            const int j = lane + 64 * i;
            const float x = p0[j] + p0[512 + 256 + j] + biasc[kv * 256 + j];
            const float t = tanhf(0.7978845608028654f * (x + 0.044715f * x * x * x));
            hb[j] = 0.5f * x * (1.f + t);
        }
        LDS_WAIT();
        const float* w2 = p.in[kv ? I_W2V : I_W2K];
        float o = p.in[kv ? I_B2V : I_B2K][lane];
#pragma unroll 8
        for (int j = 0; j < 256; ++j) o += hb[j] * w2[j * 64 + lane];
        if (kv == 0) {
            const float ss = wave_sum(o * o);
            const float y = o * rsqrtf(ss * (1.f / 64.f) + EPS) * p.in[I_KCG][lane];
            ((bf16_t*)(ws + WS_KCMP))[((size_t)g * 1024 + n) * 64 + lane] = (bf16_t)(pk2(y, 0.f) & 0xffffu);
        } else {
            ((bf16_t*)(ws + WS_VCMPT))[(((size_t)g * 32 + (n >> 5)) * 64 + lane) * 32 + (n & 31)] = (bf16_t)(pk2(o, 0.f) & 0xffffu);
        }
        LDS_WAIT();
    }
}

#define MFMA16(a, b, c) __builtin_amdgcn_mfma_f32_16x16x32_bf16((a), (b), (c), 0, 0, 0)

DI void qk_tile(const bf16_t* kbase, const bf16x8 (&qf)[4][2], f32x4 (&s)[4][2], int tl, int quad) {
    bf16x8 kf[2][2];
#pragma unroll
    for (int ks = 0; ks < 2; ++ks)
#pragma unroll
        for (int dh = 0; dh < 2; ++dh) kf[ks][dh] = *(const bf16x8*)(kbase + (ks * 16 + tl) * 64 + dh * 32 + quad * 8);
#pragma unroll
    for (int h = 0; h < 4; ++h)
#pragma unroll
        for (int ks = 0; ks < 2; ++ks) {
            f32x4 z = {0.f, 0.f, 0.f, 0.f};
            z = MFMA16(kf[ks][0], qf[h][0], z);
            s[h][ks] = MFMA16(kf[ks][1], qf[h][1], z);
        }
}
DI void pv_tile(const bf16_t* vt, const bf16x8 (&pb)[4], f32x4 (&o)[4][4], int tl, int quad) {
#pragma unroll
    for (int dt = 0; dt < 4; ++dt) {
        const u32x2 a = *(const u32x2*)(vt + (dt * 16 + tl) * 32 + 4 * quad);
        const u32x2 b = *(const u32x2*)(vt + (dt * 16 + tl) * 32 + 16 + 4 * quad);
        u32x4 w; w.x = a.x; w.y = a.y; w.z = b.x; w.w = b.y;
        const bf16x8 vf = __builtin_bit_cast(bf16x8, w);
#pragma unroll
        for (int h = 0; h < 4; ++h) o[h][dt] = MFMA16(vf, pb[h], o[h][dt]);
    }
}
template <int STRIDE>
DI void exp_tile(f32x4 (&s)[4][2], const float (&sl2)[4], float ref2, int dbase, unsigned lim) {
    float fd[2][4]; bool ok[2][4];
#pragma unroll
    for (int ks = 0; ks < 2; ++ks)
#pragma unroll
        for (int i = 0; i < 4; ++i) { const int dist = dbase - STRIDE * (16 * ks + i); fd[ks][i] = (float)dist; ok[ks][i] = (unsigned)dist < lim; }
#pragma unroll
    for (int h = 0; h < 4; ++h) {
        const float nsl = -sl2[h];
#pragma unroll
        for (int ks = 0; ks < 2; ++ks)
#pragma unroll
            for (int i = 0; i < 4; ++i) {
                const float x = fmaf(nsl, fd[ks][i], fmaf(s[h][ks][i], C2, -ref2));
                const float e = __builtin_amdgcn_exp2f(x);
                s[h][ks][i] = ok[ks][i] ? e : 0.f;
            }
    }
}
DI void pack_tile(const f32x4 (&s)[4][2], bf16x8 (&pb)[4]) {
#pragma unroll
    for (int h = 0; h < 4; ++h) pb[h] = __builtin_bit_cast(bf16x8, pack8(s[h][0], s[h][1]));
}
DI void list_insert(unsigned (&lst)[16], unsigned key) {
#pragma unroll
    for (int i = 0; i < 16; ++i) { const unsigned hi = lst[i] > key ? lst[i] : key, lo = lst[i] > key ? key : lst[i]; lst[i] = hi; key = lo; }
}

DI void attn_unit(const Params& p, int tile, int g, int lane, LAS unsigned char* wl, float ref_c, float ref_s, float ref_w) {
    unsigned char* ws = p.ws;
    const int t0 = tile * 16, tl = lane & 15, quad = lane >> 4, tok = t0 + tl, cur = t0 >> 6;
    LAS f32x4* fin = (LAS f32x4*)wl;
    LAS unsigned* lstx = (LAS unsigned*)wl;
    LAS unsigned* msk = (LAS unsigned*)(wl + 16384);
    LAS unsigned* uni = msk + 128;
    const bf16_t* Q = (const bf16_t*)(ws + WS_Q);
    const bf16_t* KC = (const bf16_t*)(ws + WS_KCMP) + (size_t)g * 1024 * 64;
    const bf16_t* VCT = (const bf16_t*)(ws + WS_VCMPT) + (size_t)g * 32 * 64 * 32;
    const bf16_t* KS = (const bf16_t*)(ws + WS_KS) + (size_t)g * SEQ * 64;
    const bf16_t* VST = (const bf16_t*)(ws + WS_VST) + (size_t)g * 512 * 64 * 32;
    const bf16_t* KW = (const bf16_t*)(ws + WS_KW) + (size_t)g * SEQ * 64;
    const bf16_t* VWT = (const bf16_t*)(ws + WS_VWT) + (size_t)g * 512 * 64 * 32;
    const float* gate = (const float*)(ws + WS_G) + (size_t)tok * 24 + g * 12;

    bf16x8 qf[4][2];
#pragma unroll
    for (int h = 0; h < 4; ++h)
#pragma unroll
        for (int dh = 0; dh < 2; ++dh) qf[h][dh] = *(const bf16x8*)(Q + (size_t)tok * 512 + (g * 4 + h) * 64 + dh * 32 + quad * 8);
    float sl2[4];
#pragma unroll
    for (int h = 0; h < 4; ++h) sl2[h] = exp2f(-(float)(g * 4 + h + 1)) * LOG2E;

    f32x4 s[4][2]; f32x4 o[4][4]; bf16x8 pb[4]; float l[4];
    const int NT = (cur >> 3) + 1;
    const int dc0 = tok - 31 - 64 * quad;
#pragma unroll
    for (int h = 0; h < 4; ++h) l[h] = 0.f;
    for (int T = 0; T < NT; ++T) {
        qk_tile(KC + (size_t)T * 32 * 64, qf, s, tl, quad);
        exp_tile<16>(s, sl2, ref_c, dc0 - 512 * T, 0x80000000u);
#pragma unroll
        for (int h = 0; h < 4; ++h) l[h] += (s[h][0][0] + s[h][0][1]) + (s[h][0][2] + s[h][0][3]) + (s[h][1][0] + s[h][1][1]) + (s[h][1][2] + s[h][1][3]);
    }
    float inv[4];
#pragma unroll
    for (int h = 0; h < 4; ++h) { float L = l[h]; L += __shfl_xor(L, 16); L += __shfl_xor(L, 32); inv[h] = L > 0.f ? 1.f / L : 0.f; }
#pragma unroll
    for (int h = 0; h < 4; ++h)
#pragma unroll
        for (int dt = 0; dt < 4; ++dt) o[h][dt] = (f32x4){0.f, 0.f, 0.f, 0.f};
    unsigned lst[16];
#pragma unroll
    for (int i = 0; i < 16; ++i) lst[i] = 0u;
    float carry = 0.f;
    for (int T = 0; T < NT; ++T) {
        qk_tile(KC + (size_t)T * 32 * 64, qf, s, tl, quad);
        exp_tile<16>(s, sl2, ref_c, dc0 - 512 * T, 0x80000000u);
        float a0 = 0.f, a1 = 0.f, b0 = 0.f, b1 = 0.f;
#pragma unroll
        for (int h = 0; h < 4; ++h) {
            s[h][0] = s[h][0] * inv[h]; s[h][1] = s[h][1] * inv[h];
            a0 += (s[h][0][0] + s[h][0][1]) + (s[h][0][2] + 0.5f * s[h][0][3]); b0 += 0.5f * s[h][0][3];
            a1 += (s[h][1][0] + s[h][1][1]) + (s[h][1][2] + 0.5f * s[h][1][3]); b1 += 0.5f * s[h][1][3];
        }
        pack_tile(s, pb);
        pv_tile(VCT + (size_t)T * 64 * 32, pb, o, tl, quad);
        const float bs0 = __shfl(b0, (lane + 48) & 63), bs1 = __shfl(b1, (lane + 48) & 63);
        const float imp0 = a0 + (quad ? bs0 : carry), imp1 = a1 + (quad ? bs1 : bs0);
        carry = bs1;
        const int j0 = 8 * T + quad, j1 = j0 + 4;
        {
            const bool forced = (j0 == 0) || (j0 == cur) || (j0 == cur - 1);
            unsigned key = forced ? 0x7F000000u : (__float_as_uint(imp0) & 0xFFFFFE00u);
            key = (j0 <= cur) ? (key | 0x100u | (unsigned)(255 - j0)) : 0u;
            list_insert(lst, key);
        }
        {
            const bool forced = (j1 == 0) || (j1 == cur) || (j1 == cur - 1);
            unsigned key = forced ? 0x7F000000u : (__float_as_uint(imp1) & 0xFFFFFE00u);
            key = (j1 <= cur) ? (key | 0x100u | (unsigned)(255 - j1)) : 0u;
            list_insert(lst, key);
        }
    }
#pragma unroll
    for (int i = 0; i < 16; ++i) lstx[(tl * 4 + quad) * 16 + i] = lst[i];
    LDS_WAIT();
    if (quad == 0) {
        for (int qq = 1; qq < 4; ++qq) {
#pragma unroll
            for (int i = 0; i < 16; ++i) list_insert(lst, lstx[(tl * 4 + qq) * 16 + i]);
        }
        unsigned mw[8];
#pragma unroll
        for (int w = 0; w < 8; ++w) mw[w] = 0u;
#pragma unroll
        for (int i = 0; i < 16; ++i) {
            const unsigned key = lst[i]; const int j = 255 - (int)(key & 0xFFu); const unsigned bit = key ? (1u << (j & 31)) : 0u;
#pragma unroll
            for (int w = 0; w < 8; ++w) mw[w] |= ((j >> 5) == w) ? bit : 0u;
        }
#pragma unroll
        for (int w = 0; w < 8; ++w) msk[tl * 8 + w] = mw[w];
    }
    LDS_WAIT();
    if (lane < 8) {
        unsigned u = 0u;
#pragma unroll
        for (int tk = 0; tk < 16; ++tk) u |= msk[tk * 8 + lane];
        uni[lane] = u;
    }
    LDS_WAIT();
#pragma unroll
    for (int h = 0; h < 4; ++h) {
        const float gc = gate[h * 3 + 0];
#pragma unroll
        for (int dt = 0; dt < 4; ++dt) fin[(h * 4 + dt) * 64 + lane] = o[h][dt] * gc;
    }
#pragma unroll
    for (int h = 0; h < 4; ++h) {
        l[h] = 0.f;
#pragma unroll
        for (int dt = 0; dt < 4; ++dt) o[h][dt] = (f32x4){0.f, 0.f, 0.f, 0.f};
    }
    for (int w = 0; w < 8; ++w) {
        unsigned uw = (unsigned)__builtin_amdgcn_readfirstlane((int)uni[w]);
        const unsigned mym = msk[tl * 8 + w];
        while (uw) {
            const int b = __builtin_ctz(uw); uw &= uw - 1u;
            const int j = w * 32 + b;
            const unsigned lim = ((mym >> b) & 1u) ? 0x80000000u : 0u;
#pragma unroll 1
            for (int half = 0; half < 2; ++half) {
                const int kb = j * 64 + half * 32;
                qk_tile(KS + (size_t)kb * 64, qf, s, tl, quad);
                exp_tile<1>(s, sl2, ref_s, tok - kb - 4 * quad, lim);
#pragma unroll
                for (int h = 0; h < 4; ++h) l[h] += (s[h][0][0] + s[h][0][1]) + (s[h][0][2] + s[h][0][3]) + (s[h][1][0] + s[h][1][1]) + (s[h][1][2] + s[h][1][3]);
                pack_tile(s, pb);
                pv_tile(VST + (size_t)(kb >> 5) * 64 * 32, pb, o, tl, quad);
            }
        }
    }
#pragma unroll
    for (int h = 0; h < 4; ++h) {
        float L = l[h]; L += __shfl_xor(L, 16); L += __shfl_xor(L, 32);
        const float wgt = gate[h * 3 + 1] / L;
#pragma unroll
        for (int dt = 0; dt < 4; ++dt) fin[(h * 4 + dt) * 64 + lane] = fin[(h * 4 + dt) * 64 + lane] + o[h][dt] * wgt;
    }
#pragma unroll
    for (int h = 0; h < 4; ++h) {
        l[h] = 0.f;
#pragma unroll
        for (int dt = 0; dt < 4; ++dt) o[h][dt] = (f32x4){0.f, 0.f, 0.f, 0.f};
    }
    {
        const int kb0 = (t0 - 512) > 0 ? ((t0 - 512) & ~31) : 0, kbl = t0 & ~31;
        for (int kb = kb0; kb <= kbl; kb += 32) {
            qk_tile(KW + (size_t)kb * 64, qf, s, tl, quad);
            exp_tile<1>(s, sl2, ref_w, tok - kb - 4 * quad, 512u);
#pragma unroll
            for (int h = 0; h < 4; ++h) l[h] += (s[h][0][0] + s[h][0][1]) + (s[h][0][2] + s[h][0][3]) + (s[h][1][0] + s[h][1][1]) + (s[h][1][2] + s[h][1][3]);
            pack_tile(s, pb);
            pv_tile(VWT + (size_t)(kb >> 5) * 64 * 32, pb, o, tl, quad);
        }
    }
    bf16_t* dst = (bf16_t*)(ws + WS_A2) + (size_t)tok * DM + 512 + g * 256 + 4 * quad;
#pragma unroll
    for (int h = 0; h < 4; ++h) {
        float L = l[h]; L += __shfl_xor(L, 16); L += __shfl_xor(L, 32);
        const float wgt = gate[h * 3 + 2] / L;
#pragma unroll
        for (int dt = 0; dt < 4; ++dt) {
            const f32x4 v = fin[(h * 4 + dt) * 64 + lane] + o[h][dt] * wgt;
            u32x2 w; w.x = pk2(v[0], v[1]); w.y = pk2(v[2], v[3]);
            *(u32x2*)(dst + h * 64 + dt * 16) = w;
        }
    }
    LDS_WAIT();
}

DI void attn_phase(const Params& p, LAS unsigned char* lds, int lane, int wave, int G) {
    LAS unsigned char* wl = lds + wave * WAVE_LDS;
    const float gq = wave_max(fabsf(p.in[I_QG][lane]));
    const float ref_c = C2 * 64.f * gq * wave_max(fabsf(p.in[I_KCG][lane]));
    const float ref_s = C2 * 64.f * gq * wave_max(fabsf(p.in[I_KSG][lane]));
    const float ref_w = C2 * 64.f * gq * wave_max(fabsf(p.in[I_KWG][lane]));
    const int sd = wave & 3, hh = wave >> 2;
    for (int pp = blockIdx.x * 4 + sd; pp < 1024; pp += G * 4) {
        const int tp = pp >> 1, g = pp & 1;
        const int tile = hh ? (1023 - tp) : tp;
        attn_unit(p, tile, g, lane, wl, ref_c, ref_s, ref_w);
    }
}

template <bool COOP, int ONLY>
__global__ void __launch_bounds__(512, 2) mega(Params p) {
    extern __shared__ __attribute__((aligned(16))) unsigned char lds_raw[];
    LAS unsigned char* lds = (LAS unsigned char*)lds_raw;
    const int tid = threadIdx.x, lane = tid & 63, wave = __builtin_amdgcn_readfirstlane(tid >> 6), G = gridDim.x;
    unsigned char* ws = p.ws;
    const int lo = p.ph_lo, hi = p.ph_hi;
#define IN(k) ((ONLY < 0 || ONLY == (k)) && lo <= (k) && (k) < hi)
#define SEAM(k) do { if (COOP && IN(k) && IN((k) + 1)) { __threadfence(); cg::this_grid().sync(); } } while (0)
    if (IN(0)) phase0(p, lds, tid, lane, wave, G);
    SEAM(0);
    if (IN(1)) phase1(p, lds, tid, lane, wave, G);
    SEAM(1);
    if (IN(2)) {
        pg8::Gemm g{(const bf16_t*)(ws + WS_XB), (const bf16_t*)(ws + WS_WINT), SEQ, NIN, DM};
        pg8::StaticOrder S; S.init(SEQ, NIN, G, (int)blockIdx.x);
        EpiIn E{(const float*)(ws + WS_RSTD1), (const float*)(ws + WS_BIASIN), p.in[I_QG], p.in[I_KSG], p.in[I_KWG],
                (bf16_t*)(ws + WS_U), (bf16_t*)(ws + WS_Q), (bf16_t*)(ws + WS_ACMP), (bf16_t*)(ws + WS_KS), (bf16_t*)(ws + WS_KW), (bf16_t*)(ws + WS_VST), (bf16_t*)(ws + WS_VWT),
                (float*)(ws + WS_G), (LAS float*)(lds + XCH_OFF)};
        pg8::gemm_phase<EpiIn, pg8::StaticOrder, true, true>(lds, g, S, E);
    }
    SEAM(2);
    if (IN(3)) {
        if (blockIdx.x < 32) {
            pg8::Gemm g{(const bf16_t*)(ws + WS_ACMP), (const bf16_t*)(ws + WS_W1CT), 4096, 1024, 1024};
            CmpOrder S{G, (int)blockIdx.x};
            EpiCmp E{(float*)(ws + WS_PCMP)};
            pg8::gemm_phase<EpiCmp, CmpOrder, true, true>(lds, g, S, E);
        } else pooled_phase(p, tid, G);
    }
    SEAM(3);
    if (IN(4)) phase4(p, lds, lane, wave, G);
    SEAM(4);
    if (IN(5)) attn_phase(p, lds, lane, wave, G);
    SEAM(5);
    if (IN(6)) {
        __syncthreads();
        pg8::Gemm g{(const bf16_t*)(ws + WS_A2), (const bf16_t*)(ws + WS_WOUTT), SEQ, DM, DM};
        pg8::StaticOrder S; S.init(SEQ, DM, G, (int)blockIdx.x);
        EpiOut E{p.in[I_X], (const float*)(ws + WS_MOD) + 2 * DM, p.out, (bf16_t*)(ws + WS_XB), (float*)(ws + WS_RSS2)};
        pg8::gemm_phase<EpiOut, pg8::StaticOrder, true, true>(lds, g, S, E);
    }
    SEAM(6);
    if (IN(7)) {
        pg8::Gemm g{(const bf16_t*)(ws + WS_XB), (const bf16_t*)(ws + WS_WFF1T), SEQ, FF, DM};
        pg8::StaticOrder S; S.init(SEQ, FF, G, (int)blockIdx.x);
        EpiFF1 E{(const float*)(ws + WS_RSS2), (const float*)(ws + WS_BIASFF), (bf16_t*)(ws + WS_H)};
        pg8::gemm_phase<EpiFF1, pg8::StaticOrder, true, true>(lds, g, S, E);
    }
    SEAM(7);
    if (IN(8)) {
        pg8::Gemm g{(const bf16_t*)(ws + WS_H), (const bf16_t*)(ws + WS_WFF2T), SEQ, DM, FF};
        pg8::StaticOrder S; S.init(SEQ, DM, G, (int)blockIdx.x);
        EpiFF2 E{(const float*)(ws + WS_MOD) + 5 * DM, p.out};
        pg8::gemm_phase<EpiFF2, pg8::StaticOrder, true, true>(lds, g, S, E);
    }
#undef IN
#undef SEAM
}

#ifndef N_LAUNCH_MODE
#define N_LAUNCH_MODE 9
#endif
#if N_LAUNCH_MODE == 1
#define QUERY_KERNEL mega<true, -1>
#else
#define QUERY_KERNEL mega<false, 2>
template <int K> static void launch_phase(int grid, Params p, hipStream_t stream) {
    p.ph_lo = K; p.ph_hi = K + 1;
    (void)hipFuncSetAttribute((const void*)mega<false, K>, hipFuncAttributeMaxDynamicSharedMemorySize, LDS_BYTES);
    hipLaunchKernelGGL((mega<false, K>), dim3(grid), dim3(512), LDS_BYTES, stream, p);
}
#endif
extern "C" void kernel_launch(void* const* d_in, const int* in_sizes, int n_in, void* d_out, int out_size, void* d_ws, size_t ws_size, hipStream_t stream) {
    static int grid = 0;
    if (grid == 0) {
        if (n_in != 26 || out_size != SEQ * DM || ws_size < WS_END) { fprintf(stderr, "kernel_launch: unexpected problem shape (n_in %d out %d ws %zu)\n", n_in, out_size, ws_size); grid = -1; return; }
        int dev = 0, cus = 0, per_cu = 0;
        (void)hipGetDevice(&dev);
        (void)hipDeviceGetAttribute(&cus, hipDeviceAttributeMultiprocessorCount, dev);
        (void)hipFuncSetAttribute((const void*)QUERY_KERNEL, hipFuncAttributeMaxDynamicSharedMemorySize, LDS_BYTES);
        (void)hipOccupancyMaxActiveBlocksPerMultiprocessor(&per_cu, (const void*)QUERY_KERNEL, 512, LDS_BYTES);
        if (per_cu < 1) { fprintf(stderr, "kernel_launch: occupancy query says %d blocks/CU\n", per_cu); per_cu = 1; }
        grid = cus;
        (void)hipGetLastError();
    }
    if (grid < 0) return;
    Params p{};
    for (int i = 0; i < 26; ++i) p.in[i] = (const float*)d_in[i];
    p.out = (float*)d_out; p.ws = (unsigned char*)d_ws;
#if N_LAUNCH_MODE == 1
    p.ph_lo = 0; p.ph_hi = 9;
    void* args[] = {&p};
    hipError_t e = hipLaunchCooperativeKernel((const void*)mega<true, -1>, dim3(grid), dim3(512), args, LDS_BYTES, stream);
    if (e != hipSuccess) fprintf(stderr, "cooperative launch failed: %s (grid %d)\n", hipGetErrorString(e), grid);
#else
    launch_phase<0>(grid, p, stream); launch_phase<1>(grid, p, stream); launch_phase<2>(grid, p, stream);
    launch_phase<3>(grid, p, stream); launch_phase<4>(grid, p, stream); launch_phase<5>(grid, p, stream);
    launch_phase<6>(grid, p, stream); launch_phase<7>(grid, p, stream); launch_phase<8>(grid, p, stream);
#endif
}
```

```cpp
#include <hip/hip_runtime.h>
#include <hip/hip_cooperative_groups.h>
#include <cstdio>
#include <cstdint>
namespace cg = cooperative_groups;
namespace pg8 {
#define PG8_LAS __attribute__((address_space(3)))
typedef unsigned short bf16_t;
typedef short bf16x8 __attribute__((ext_vector_type(8)));
typedef float f32x4 __attribute__((ext_vector_type(4)));
typedef unsigned u32x4 __attribute__((ext_vector_type(4)));
constexpr int BM = 256, BK = 64, HALF = 128, HTB = HALF * BK * 2  , STAGE_BYTES = 8 * HTB, NXCD = 8, WGM = 8;

__host__ __device__ __forceinline__ int lds_byte(int r, int c) { const int st = (r >> 4) * 2 + (c >> 5), rr = r & 15, cc = c & 31, ob = rr * 64 + cc * 2; return st * 1024 + (ob ^ (((ob >> 9) & 1) << 5)); }
__host__ __device__ __forceinline__ void stage_rc(int b, int& R, int& C) { const int st = b / 1024, sb = b % 1024, swz = sb ^ (((sb >> 9) & 1) << 5); R = (st >> 1) * 16 + swz / 64; C = (st & 1) * 32 + (swz % 64) / 2; }
__host__ __device__ __forceinline__ int perm32(int rho) { const int n = rho >> 4, i = rho & 15; return 8 * (i >> 2) + 4 * n + (i & 3); }

struct Unit { int pm, pn; };
struct Gemm { const bf16_t* A; const bf16_t* Bt; int M, N, K; };

struct StaticOrder {
    int nM, nN, nwg, G, c;
    __host__ __device__ void init(int M, int N, int G_, int c_) { nM = M / BM; nN = N / BM; nwg = nM * nN; G = G_; c = c_; }
    __host__ __device__ bool next(int i, Unit& u) const {
        const long L = (long)i * G + c; if (L >= nwg) return false;
        int wgid = (int)L; { const int q = nwg / NXCD, r = nwg % NXCD, xcd = wgid % NXCD, off = wgid / NXCD; wgid = (xcd < r ? xcd * (q + 1) : r * (q + 1) + (xcd - r) * q) + off; }
        const int nig = WGM * nN, gid = wgid / nig, fm = gid * WGM, gsz = (nM - fm) < WGM ? (nM - fm) : WGM;
        u.pm = fm + ((wgid % nig) % gsz); u.pn = (wgid % nig) / gsz; return true;
    }
    __device__ __forceinline__ void a_ready(const Unit&) const {}
    __device__ __forceinline__ void done(const Unit&) const {}
};

__device__ __forceinline__ unsigned cvt_pk_bf16(float lo, float hi) { unsigned r; asm volatile("v_cvt_pk_bf16_f32 %0, %1, %2" : "=v"(r) : "v"(lo), "v"(hi)); return r; }
template <class Epi, class Sched, bool ALIGN_EPI = false, bool SP2 = false>
__device__ __forceinline__ void gemm_phase(PG8_LAS unsigned char* lds, const Gemm g, const Sched& S, const Epi& E) {
    const int tid = threadIdx.x, wid = __builtin_amdgcn_readfirstlane(tid >> 6), lane = tid & 63, wr = wid >> 2, wc = wid & 3, fr = lane & 15, fq = lane >> 4;
    const int K = g.K, nt = K / BK;
    unsigned voffA[2], voffB[2];
#pragma unroll
    for (int i = 0; i < 2; ++i) { int R, C; stage_rc(tid * 16 + i * 8192, R, C); const int Rb = Epi::PERM ? ((R & ~31) + perm32(R & 31)) : R;
        voffA[i] = (unsigned)(R * K + C) * 2u; voffB[i] = (unsigned)(Rb * K + C) * 2u; }
    const size_t kstep = (size_t)(BK * 2);
    const size_t hstep = (size_t)HALF * K * 2;
    const size_t tstep = 2 * hstep;
    const unsigned ldsw = (unsigned)wid * 1024u;
    const int aoff = lds_byte(wr * 64 + fr, fq * 8), boff = lds_byte(wc * 32 + fr, fq * 8);
#define PG8_SA(b, h) (((b) * 2 + (h)) * HTB)
#define PG8_SB(b, h) ((4 + (b) * 2 + (h)) * HTB)
#define PG8_STAGE(bufoff, gbase, voff) do { _Pragma("unroll") for (int _i = 0; _i < 2; ++_i) \
        __builtin_amdgcn_global_load_lds((const unsigned*)((const char*)(gbase) + (voff)[_i]), (PG8_LAS unsigned*)(lds + (bufoff) + ldsw + _i * 8192), 16, 0, 0); } while (0)
#define PG8_LDA(dst, b, h) do { _Pragma("unroll") for (int m = 0; m < 4; ++m) _Pragma("unroll") for (int k = 0; k < 2; ++k) dst[m][k] = *(const PG8_LAS bf16x8*)(lds + PG8_SA(b, h) + aoff + m * 2048 + k * 1024); } while (0)
#define PG8_LDB(dst, b, h) do { _Pragma("unroll") for (int n = 0; n < 2; ++n) _Pragma("unroll") for (int k = 0; k < 2; ++k) dst[n][k] = *(const PG8_LAS bf16x8*)(lds + PG8_SB(b, h) + boff + n * 2048 + k * 1024); } while (0)
#define PG8_MMA(ai, bj, At, Bt) do { __builtin_amdgcn_s_setprio(1); _Pragma("unroll") for (int m = 0; m < 4; ++m) _Pragma("unroll") for (int n = 0; n < 2; ++n) _Pragma("unroll") for (int k = 0; k < 2; ++k) \
        acc[ai][bj][m][n] = __builtin_amdgcn_mfma_f32_16x16x32_bf16(Bt[n][k], At[m][k], acc[ai][bj][m][n], 0, 0, 0); __builtin_amdgcn_s_setprio(0); } while (0)
#define PG8_WAIT_V(n) asm volatile("s_waitcnt vmcnt(" #n ")" ::: "memory")
#define PG8_WAIT_L(n) asm volatile("s_waitcnt lgkmcnt(" #n ")" ::: "memory")
#define PG8_BAR __builtin_amdgcn_s_barrier()
#define PG8_SCHED __builtin_amdgcn_sched_barrier(0)
    Unit cur, nxt; int ui = 0;
    if (!S.next(0, cur)) return;
    f32x4 acc[2][2][4][2];
#pragma unroll
    for (int a = 0; a < 2; ++a)
#pragma unroll
        for (int b = 0; b < 2; ++b)
#pragma unroll
            for (int m = 0; m < 4; ++m)
#pragma unroll
                for (int n = 0; n < 2; ++n) acc[a][b][m][n] = (f32x4){0.f, 0.f, 0.f, 0.f};
    bf16x8 At[4][2], B0[2][2], B1[2][2];
    const char* cA = (const char*)g.A + (size_t)cur.pm * tstep; const char* cB = (const char*)g.Bt + (size_t)cur.pn * tstep;
    S.a_ready(cur);
    if constexpr (SP2) {
        PG8_STAGE(PG8_SB(0, 0), cB, voffB); PG8_STAGE(PG8_SB(0, 1), cB + hstep, voffB); PG8_STAGE(PG8_SA(0, 0), cA, voffA); PG8_STAGE(PG8_SA(0, 1), cA + hstep, voffA);
        if (wr == 1) PG8_BAR;
        PG8_WAIT_V(2); PG8_BAR;
        PG8_STAGE(PG8_SB(1, 0), cB + kstep, voffB); PG8_STAGE(PG8_SA(1, 0), cA + kstep, voffA); PG8_STAGE(PG8_SB(1, 1), cB + hstep + kstep, voffB);
        PG8_WAIT_V(6); PG8_BAR;
    } else {
        PG8_STAGE(PG8_SB(0, 0), cB, voffB); PG8_STAGE(PG8_SA(0, 0), cA, voffA); PG8_STAGE(PG8_SB(0, 1), cB + hstep, voffB); PG8_STAGE(PG8_SA(0, 1), cA + hstep, voffA);
        if (wr == 1) PG8_BAR;
        PG8_WAIT_V(4); PG8_BAR;
        PG8_STAGE(PG8_SB(1, 0), cB + kstep, voffB); PG8_STAGE(PG8_SA(1, 0), cA + kstep, voffA); PG8_STAGE(PG8_SB(1, 1), cB + hstep + kstep, voffB);
        PG8_WAIT_V(6); PG8_BAR;
    }
    for (;;) {
        const bool has_next = S.next(ui + 1, nxt);
        const char* nA = has_next ? (const char*)g.A + (size_t)nxt.pm * tstep : cA; const char* nB = has_next ? (const char*)g.Bt + (size_t)nxt.pn * tstep : cB;
        for (int t = 0; t < nt; t += 2) {
            const bool last = (t == nt - 2);
            const char* a1 = cA + (size_t)(t + 1) * kstep;
            const char* a2 = last ? nA : cA + (size_t)(t + 2) * kstep; const char* b2 = last ? nB : cB + (size_t)(t + 2) * kstep;
            const char* a3 = a2 + kstep; const char* b3 = b2 + kstep;
            if (last && has_next) S.a_ready(nxt);
            if constexpr (SP2) {
            PG8_LDB(B0, 0, 0); PG8_LDB(B1, 0, 1); PG8_SCHED; PG8_LDA(At, 0, 0); PG8_STAGE(PG8_SA(1, 1), a1 + hstep, voffA);
            PG8_WAIT_V(8); PG8_WAIT_L(0); PG8_BAR; PG8_MMA(0, 0, At, B0); PG8_MMA(0, 1, At, B1); PG8_BAR; PG8_SCHED;
            PG8_LDA(At, 0, 1); PG8_STAGE(PG8_SB(0, 0), b2, voffB); PG8_STAGE(PG8_SB(0, 1), b2 + hstep, voffB); PG8_STAGE(PG8_SA(0, 0), a2, voffA);
            PG8_WAIT_V(8); PG8_WAIT_L(0); PG8_BAR; PG8_MMA(1, 0, At, B0); PG8_MMA(1, 1, At, B1); PG8_BAR; PG8_SCHED;
            PG8_LDB(B0, 1, 0); PG8_LDB(B1, 1, 1); PG8_SCHED; PG8_LDA(At, 1, 0); PG8_STAGE(PG8_SA(0, 1), a2 + hstep, voffA);
            PG8_WAIT_V(8); PG8_WAIT_L(0); PG8_BAR; PG8_MMA(0, 0, At, B0); PG8_MMA(0, 1, At, B1); PG8_BAR; PG8_SCHED;
            PG8_LDA(At, 1, 1); PG8_STAGE(PG8_SB(1, 0), b3, voffB); PG8_STAGE(PG8_SB(1, 1), b3 + hstep, voffB); PG8_STAGE(PG8_SA(1, 0), a3, voffA);
            PG8_WAIT_V(8); PG8_WAIT_L(0); PG8_BAR; PG8_MMA(1, 0, At, B0); PG8_MMA(1, 1, At, B1); PG8_BAR; PG8_SCHED;
            } else {
            PG8_LDB(B0, 0, 0); PG8_SCHED; PG8_LDA(At, 0, 0); PG8_STAGE(PG8_SA(1, 1), a1 + hstep, voffA);
            PG8_WAIT_L(8); PG8_BAR; PG8_WAIT_L(0); PG8_MMA(0, 0, At, B0); PG8_BAR; PG8_SCHED;
            PG8_LDB(B1, 0, 1); PG8_STAGE(PG8_SB(0, 0), b2, voffB);
            PG8_BAR; PG8_WAIT_L(0); PG8_MMA(0, 1, At, B1); PG8_BAR;
            PG8_LDA(At, 0, 1); PG8_STAGE(PG8_SA(0, 0), a2, voffA);
            PG8_BAR; PG8_WAIT_L(0); PG8_MMA(1, 0, At, B0); PG8_BAR; PG8_SCHED;
            PG8_STAGE(PG8_SB(0, 1), b2 + hstep, voffB);
            PG8_WAIT_V(6); PG8_BAR; PG8_MMA(1, 1, At, B1); PG8_BAR;
            PG8_LDB(B0, 1, 0); PG8_SCHED; PG8_LDA(At, 1, 0); PG8_STAGE(PG8_SA(0, 1), a2 + hstep, voffA);
            PG8_WAIT_L(8); PG8_BAR; PG8_WAIT_L(0); PG8_MMA(0, 0, At, B0); PG8_BAR; PG8_SCHED;
            PG8_LDB(B1, 1, 1); PG8_STAGE(PG8_SB(1, 0), b3, voffB);
            PG8_BAR; PG8_WAIT_L(0); PG8_MMA(0, 1, At, B1); PG8_BAR;
            PG8_LDA(At, 1, 1); PG8_STAGE(PG8_SA(1, 0), a3, voffA);
            PG8_BAR; PG8_WAIT_L(0); PG8_MMA(1, 0, At, B0); PG8_BAR; PG8_SCHED;
            PG8_STAGE(PG8_SB(1, 1), b3 + hstep, voffB);
            PG8_WAIT_V(6); PG8_BAR; PG8_MMA(1, 1, At, B1); PG8_BAR;
            }
        }
        if constexpr (ALIGN_EPI) { if (wr == 0) PG8_BAR; }
        if constexpr (!Epi::AFTER_DRAIN) { E(acc, cur, wr, wc, fr, fq); S.done(cur); }
        if (!has_next) break;
#pragma unroll
        for (int a = 0; a < 2; ++a)
#pragma unroll
            for (int b = 0; b < 2; ++b)
#pragma unroll
                for (int m = 0; m < 4; ++m)
#pragma unroll
                    for (int n = 0; n < 2; ++n) acc[a][b][m][n] = (f32x4){0.f, 0.f, 0.f, 0.f};
        cur = nxt; cA = nA; cB = nB; ++ui;
        if constexpr (ALIGN_EPI) { if (wr == 1) PG8_BAR; }
    }
    PG8_WAIT_V(0);
    if constexpr (!ALIGN_EPI) { if (wr == 0) PG8_BAR; }
    PG8_BAR;
    if constexpr (Epi::AFTER_DRAIN) { E.fused(acc, cur, wr, wc, fr, fq, lds, wid, lane); S.done(cur); }
#undef PG8_SA
#undef PG8_SB
#undef PG8_STAGE
#undef PG8_LDA
#undef PG8_LDB
#undef PG8_MMA
#undef PG8_WAIT_V
#undef PG8_WAIT_L
#undef PG8_BAR
#undef PG8_SCHED
}
}

using pg8::bf16_t; using pg8::bf16x8; using pg8::f32x4; using pg8::u32x4;
#define LAS __attribute__((address_space(3)))
#define DI __device__ __forceinline__
#define LDS_WAIT() asm volatile("s_waitcnt lgkmcnt(0)" ::: "memory")
typedef unsigned u32x2 __attribute__((ext_vector_type(2)));

constexpr int SEQ = 16384, DM = 1024, NIN = 2048, INW = 1816, FF = 4096;
constexpr float EPS = 1e-6f;
constexpr float LOG2E = 1.4426950408889634f;
constexpr float C2 = 0.125f * LOG2E;
constexpr size_t MiB = 1u << 20;
constexpr size_t WS_MOD = 1 * MiB;
constexpr size_t WS_BIASIN = WS_MOD + 32768;
constexpr size_t WS_BIASFF = WS_BIASIN + 8192;
constexpr size_t WS_BIASC = WS_BIASFF + 16384;
constexpr size_t WS_RSTD1 = WS_BIASC + 2048;
constexpr size_t WS_RSS2 = WS_RSTD1 + 65536;
constexpr size_t WS_G = 2 * MiB;
constexpr size_t WS_KCMP = 4 * MiB;
constexpr size_t WS_VCMPT = 4 * MiB + 262144;
constexpr size_t WS_WINT = 5 * MiB;
constexpr size_t WS_WOUTT = 9 * MiB;
constexpr size_t WS_WFF1T = 11 * MiB;
constexpr size_t WS_WFF2T = 19 * MiB;
constexpr size_t WS_W1CT = 27 * MiB;
constexpr size_t WS_PCMP = 29 * MiB;
constexpr size_t WS_XB = 40 * MiB;
constexpr size_t WS_H = 72 * MiB;
constexpr size_t WS_U = 72 * MiB;
constexpr size_t WS_Q = 88 * MiB;
constexpr size_t WS_ACMP = 104 * MiB;
constexpr size_t WS_KS = 112 * MiB;
constexpr size_t WS_KW = 116 * MiB;
constexpr size_t WS_VST = 120 * MiB;
constexpr size_t WS_VWT = 124 * MiB;
constexpr size_t WS_A2 = 128 * MiB;
constexpr size_t WS_END = 200 * MiB;
constexpr int LDS_BYTES = 147456;
constexpr int XCH_OFF = 131072;
constexpr int WAVE_LDS = 17408;

struct Params {
    const float* in[26];
    float* out;
    unsigned char* ws;
    int ph_lo, ph_hi;
};
enum { I_X = 0, I_C, I_WADA, I_BADA, I_N1G, I_N2G, I_WIN, I_WPOOL, I_PSCALE, I_QG, I_KCG, I_KSG, I_KWG,
       I_POSK, I_W1K, I_B1K, I_W2K, I_B2K, I_POSV, I_W1V, I_B1V, I_W2V, I_B2V, I_WOUT, I_WFF1, I_WFF2 };

DI unsigned pk2(float lo, float hi) { return pg8::cvt_pk_bf16(lo, hi); }
DI float bf2f(unsigned short h) { return __uint_as_float((unsigned)h << 16); }
DI float wave_sum(float v) {
#pragma unroll
    for (int o = 1; o < 64; o <<= 1) v += __shfl_xor(v, o);
    return v;
}
DI float wave_max(float v) {
#pragma unroll
    for (int o = 1; o < 64; o <<= 1) v = fmaxf(v, __shfl_xor(v, o));
    return v;
}

DI void gemv_item(const float* v, const float* W, int ldw, int K, int j0, int nvalid, const float* bias, float* out, LAS float* red, int tid) {
    const int c = tid & 31, kp = tid >> 5, j = j0 + c;
    float s = 0.f;
    if (j < nvalid) {
#pragma unroll 8
        for (int k = kp; k < K; k += 16) s += v[k] * W[(size_t)k * ldw + j];
    }
    red[kp * 32 + c] = s;
    __syncthreads();
    if (tid < 32) {
        float t = 0.f;
#pragma unroll
        for (int i = 0; i < 16; ++i) t += red[i * 32 + tid];
        if (j0 + tid < nvalid) out[j0 + tid] = t + (bias ? bias[j0 + tid] : 0.f);
    }
    __syncthreads();
}

DI void transpose_item(const float* W, int ldw, int k0, int n0, int nvalid, const float* sg, const float* sm, bf16_t* WT, int ldt, int row_off, int col_off, LAS float* scr, int lane) {
#pragma unroll 8
    for (int i = 0; i < 32; ++i) {
        const int kk = 2 * i + (lane >> 5), n = n0 + (lane & 31);
        float v = (n < nvalid) ? W[(size_t)(k0 + kk) * ldw + n] : 0.f;
        if (sg) v *= sg[k0 + kk] * (1.f + sm[k0 + kk]);
        scr[kk * 33 + (lane & 31)] = v;
    }
    LDS_WAIT();
    const int c = lane & 7;
#pragma unroll
    for (int j = 0; j < 4; ++j) {
        const int n = (lane >> 3) + 8 * j; const LAS float* s = scr + (8 * c) * 33 + n;
        u32x4 o; o.x = pk2(s[0 * 33], s[1 * 33]); o.y = pk2(s[2 * 33], s[3 * 33]); o.z = pk2(s[4 * 33], s[5 * 33]); o.w = pk2(s[6 * 33], s[7 * 33]);
        *(u32x4*)(WT + (size_t)(row_off + n0 + n) * ldt + col_off + k0 + 8 * c) = o;
    }
    LDS_WAIT();
}

DI void phase0(const Params& p, LAS unsigned char* lds, int tid, int lane, int wave, int G) {
    unsigned char* ws = p.ws;
    float* mod = (float*)(ws + WS_MOD);
    LAS float* red = (LAS float*)(lds + XCH_OFF);
    for (int it = blockIdx.x; it < 192 + 16; it += G) {
        if (it < 192) gemv_item(p.in[I_C], p.in[I_WADA], 6 * DM, DM, it * 32, 6 * DM, p.in[I_BADA], mod, red, tid);
        else { const int r = it - 192, kv = r >> 3, j0 = (r & 7) * 32;
            gemv_item(p.in[kv ? I_POSV : I_POSK], p.in[kv ? I_W1V : I_W1K], 256, 2048, j0, 256, p.in[kv ? I_B1V : I_B1K], (float*)(ws + WS_BIASC) + kv * 256, red, tid); }
    }
    LAS float* scr = (LAS float*)(lds + wave * 16384);
    const int gw = blockIdx.x * 8 + wave, NGW = G * 8;
    constexpr int N_ROWS = SEQ, N_TO = 8 * 32, N_T2 = 64 * 32, N_TC = 4 * 128, N_WC = 512, N_Z1 = 512, N_Z2 = 64;
    constexpr int NITEMS = N_ROWS + N_TO + N_T2 + N_TC + N_WC + N_Z1 + N_Z2;
    for (int it = gw; it < NITEMS; it += NGW) {
        int r = it;
        if (r < N_ROWS) {
            const f32x4* xr = (const f32x4*)(p.in[I_X] + (size_t)r * DM) + lane;
            f32x4 v[4]; float s = 0.f;
#pragma unroll
            for (int j = 0; j < 4; ++j) { v[j] = xr[64 * j]; s += (v[j].x * v[j].x + v[j].y * v[j].y) + (v[j].z * v[j].z + v[j].w * v[j].w); }
            s = wave_sum(s);
            if (lane == 0) ((float*)(ws + WS_RSTD1))[r] = rsqrtf(s * (1.f / DM) + EPS);
            u32x2* o8 = (u32x2*)((bf16_t*)(ws + WS_XB) + (size_t)r * DM) + lane;
#pragma unroll
            for (int j = 0; j < 4; ++j) { u32x2 o; o.x = pk2(v[j].x, v[j].y); o.y = pk2(v[j].z, v[j].w); o8[64 * j] = o; }
            continue;
        }
        r -= N_ROWS;
        if (r < N_TO) {
            transpose_item(p.in[I_WOUT] + (size_t)512 * DM, DM, (r >> 5) * 64, (r & 31) * 32, DM, nullptr, nullptr, (bf16_t*)(ws + WS_WOUTT), DM, 0, 512, scr, lane);
            continue;
        }
        r -= N_TO;
        if (r < N_T2) {
            transpose_item(p.in[I_WFF2], DM, (r >> 5) * 64, (r & 31) * 32, DM, nullptr, nullptr, (bf16_t*)(ws + WS_WFF2T), FF, 0, 0, scr, lane);
            continue;
        }
        r -= N_T2;
        if (r < N_TC) {
            const int piece = r >> 7, q = r & 127, kv = piece >> 1, half = piece & 1;
            transpose_item(p.in[kv ? I_W1V : I_W1K] + (size_t)half * 1024 * 256, 256, (q >> 3) * 64, (q & 7) * 32, 256, nullptr, nullptr, (bf16_t*)(ws + WS_W1CT), 1024, piece * 256, 0, scr, lane);
            continue;
        }
        r -= N_TC;
        if (r < N_WC) {
            const int g = r >> 7, nt = (r >> 3) & 15, cc = r & 7, n = nt * 64 + lane;
            const float* wp = p.in[I_WPOOL] + (size_t)(g * 128 + cc * 16) * 128;
            const float* ps = p.in[I_PSCALE] + g * 128;
            const float* wo = p.in[I_WOUT] + (size_t)(g * 128) * DM + n;
            float acc[16];
#pragma unroll
            for (int i = 0; i < 16; ++i) acc[i] = 0.f;
            for (int d = 0; d < 128; ++d) {
                const float z = ps[d] * wo[(size_t)d * DM];
#pragma unroll
                for (int i = 0; i < 16; ++i) acc[i] += wp[i * 128 + d] * z;
            }
            u32x4 o0, o1;
            o0.x = pk2(acc[0], acc[1]); o0.y = pk2(acc[2], acc[3]); o0.z = pk2(acc[4], acc[5]); o0.w = pk2(acc[6], acc[7]);
            o1.x = pk2(acc[8], acc[9]); o1.y = pk2(acc[10], acc[11]); o1.z = pk2(acc[12], acc[13]); o1.w = pk2(acc[14], acc[15]);
            bf16_t* dst = (bf16_t*)(ws + WS_WOUTT) + (size_t)n * DM + g * 128 + cc * 16;
            *(u32x4*)dst = o0; *(u32x4*)(dst + 8) = o1;
            continue;
        }
        r -= N_WC;
        if (r < N_Z1) { u32x4 z = {0u, 0u, 0u, 0u}; *((u32x4*)(ws + WS_KCMP) + (size_t)r * 64 + lane) = z; continue; }
        r -= N_Z1;
        { u32x4 z = {0u, 0u, 0u, 0u}; *((u32x4*)(ws + WS_RSS2) + (size_t)r * 64 + lane) = z; }
    }
}

DI void phase1(const Params& p, LAS unsigned char* lds, int tid, int lane, int wave, int G) {
    unsigned char* ws = p.ws;
    const float* mod = (const float*)(ws + WS_MOD);
    LAS float* red = (LAS float*)(lds + XCH_OFF);
    for (int it = blockIdx.x; it < 57 + 128; it += G) {
        if (it < 57) gemv_item(mod + 0, p.in[I_WIN], INW, DM, it * 32, INW, nullptr, (float*)(ws + WS_BIASIN), red, tid);
        else gemv_item(mod + 3 * DM, p.in[I_WFF1], FF, DM, (it - 57) * 32, FF, nullptr, (float*)(ws + WS_BIASFF), red, tid);
    }
    LAS float* scr = (LAS float*)(lds + wave * 16384);
    const int gw = blockIdx.x * 8 + wave, NGW = G * 8;
    constexpr int N_TI = 16 * 57, N_T1 = 16 * 128;
    for (int it = gw; it < N_TI + N_T1; it += NGW) {
        if (it < N_TI) transpose_item(p.in[I_WIN], INW, (it / 57) * 64, (it % 57) * 32, INW, p.in[I_N1G], mod + 1 * DM, (bf16_t*)(ws + WS_WINT), DM, 0, 0, scr, lane);
        else { const int r = it - N_TI; transpose_item(p.in[I_WFF1], FF, (r >> 7) * 64, (r & 127) * 32, FF, p.in[I_N2G], mod + 4 * DM, (bf16_t*)(ws + WS_WFF1T), DM, 0, 0, scr, lane); }
    }
}

DI u32x4 pack8(const f32x4& a, const f32x4& b) { u32x4 w; w.x = pk2(a[0], a[1]); w.y = pk2(a[2], a[3]); w.z = pk2(b[0], b[1]); w.w = pk2(b[2], b[3]); return w; }

struct EpiIn {
    static constexpr bool PERM = true, AFTER_DRAIN = false;
    const float* rstd1; const float* bias; const float* q_gain; const float* ks_gain; const float* kw_gain;
    bf16_t *U, *Q, *ACMP, *KS, *KW, *VST, *VWT; float* G; LAS float* xch;
    DI void operator()(const f32x4 (&acc)[2][2][4][2], const pg8::Unit& u, int wr, int wc, int fr, int fq) const {
        const int pn = u.pn, row0 = u.pm * 256 + wr * 64 + fr, wid = wr * 4 + wc;
        const int colb = pn * 256 + wc * 32 + 8 * fq;
        const int gsel = wc >> 1, d0 = (wc & 1) * 32 + 8 * fq;
#pragma unroll
        for (int bj = 0; bj < 2; ++bj) {
            float ss[2][4];
#pragma unroll
            for (int ai = 0; ai < 2; ++ai)
#pragma unroll
                for (int m = 0; m < 4; ++m) {
                    const float rsv = rstd1[row0 + ai * 128 + m * 16];
                    const f32x4 v0 = acc[ai][bj][m][0] * rsv + *(const f32x4*)(bias + colb + bj * 128), v1 = acc[ai][bj][m][1] * rsv + *(const f32x4*)(bias + colb + bj * 128 + 4);
                    float s = (v0[0] * v0[0] + v0[1] * v0[1]) + (v0[2] * v0[2] + v0[3] * v0[3]) + (v1[0] * v1[0] + v1[1] * v1[1]) + (v1[2] * v1[2] + v1[3] * v1[3]);
                    s += __shfl_xor(s, 16); s += __shfl_xor(s, 32);
                    ss[ai][m] = s;
                }
            if (fq == 0) {
#pragma unroll
                for (int ai = 0; ai < 2; ++ai)
#pragma unroll
                    for (int m = 0; m < 4; ++m) xch[wid * 256 + ((bj * 2 + ai) * 4 + m) * 16 + fr] = ss[ai][m];
            }
            LDS_WAIT(); __builtin_amdgcn_s_barrier(); asm volatile("" ::: "memory");
#pragma unroll
            for (int ai = 0; ai < 2; ++ai)
#pragma unroll
                for (int m = 0; m < 4; ++m) ss[ai][m] += xch[(wid ^ 1) * 256 + ((bj * 2 + ai) * 4 + m) * 16 + fr];
#pragma unroll
            for (int ai = 0; ai < 2; ++ai)
#pragma unroll
                for (int m = 0; m < 4; ++m) {
                    const int row = row0 + ai * 128 + m * 16;
                    const float rsv = rstd1[row];
                    f32x4 v0 = acc[ai][bj][m][0] * rsv + *(const f32x4*)(bias + colb + bj * 128), v1 = acc[ai][bj][m][1] * rsv + *(const f32x4*)(bias + colb + bj * 128 + 4);
                    if (pn < 2) {
                        *(u32x4*)(U + (size_t)row * 512 + pn * 256 + bj * 128 + wc * 32 + 8 * fq) = pack8(v0, v1);
                    } else if (pn < 4) {
                        const float rn = rsqrtf(ss[ai][m] * (1.f / 64.f) + EPS);
                        const f32x4 g0 = *(const f32x4*)(q_gain + d0), g1 = *(const f32x4*)(q_gain + d0 + 4);
                        v0 = v0 * rn * g0; v1 = v1 * rn * g1;
                        *(u32x4*)(Q + (size_t)row * 512 + (pn - 2) * 256 + bj * 128 + wc * 32 + 8 * fq) = pack8(v0, v1);
                    } else if (pn == 4) {
                        *(u32x4*)(ACMP + ((size_t)(bj * 2 + gsel) * SEQ + row) * 64 + d0) = pack8(v0, v1);
                    } else if (pn < 7) {
                        if (bj == 0) {
                            const float* gain = (pn == 5) ? ks_gain : kw_gain;
                            const float rn = rsqrtf(ss[ai][m] * (1.f / 64.f) + EPS);
                            const f32x4 g0 = *(const f32x4*)(gain + d0), g1 = *(const f32x4*)(gain + d0 + 4);
                            v0 = v0 * rn * g0; v1 = v1 * rn * g1;
                            bf16_t* K = (pn == 5) ? KS : KW;
                            *(u32x4*)(K + ((size_t)gsel * SEQ + row) * 64 + d0) = pack8(v0, v1);
                        } else {
                            bf16_t* VT = ((pn == 5) ? VST : VWT) + (((size_t)gsel * 512 + (row >> 5)) * 64 + d0) * 32 + (row & 31);
                            const u32x4 w = pack8(v0, v1);
                            VT[0 * 32] = (bf16_t)(w.x & 0xffffu); VT[1 * 32] = (bf16_t)(w.x >> 16); VT[2 * 32] = (bf16_t)(w.y & 0xffffu); VT[3 * 32] = (bf16_t)(w.y >> 16);
                            VT[4 * 32] = (bf16_t)(w.z & 0xffffu); VT[5 * 32] = (bf16_t)(w.z >> 16); VT[6 * 32] = (bf16_t)(w.w & 0xffffu); VT[7 * 32] = (bf16_t)(w.w >> 16);
                        }
                    } else {
                        if (bj == 0 && wc == 0 && fq < 3) {
                            f32x4 s0, s1;
#pragma unroll
                            for (int i = 0; i < 4; ++i) { s0[i] = 1.f / (1.f + __expf(-v0[i])); s1[i] = 1.f / (1.f + __expf(-v1[i])); }
                            *(f32x4*)(G + (size_t)row * 24 + 8 * fq) = s0; *(f32x4*)(G + (size_t)row * 24 + 8 * fq + 4) = s1;
                        }
                    }
                }
        }
    }
};

struct EpiCmp {
    static constexpr bool PERM = true, AFTER_DRAIN = false;
    float* P;
    DI void operator()(const f32x4 (&acc)[2][2][4][2], const pg8::Unit& u, int wr, int wc, int fr, int fq) const {
        const int row0 = u.pm * 256 + wr * 64 + fr, col0 = (u.pn & 1) * 256 + wc * 32 + 8 * fq;
#pragma unroll
        for (int ai = 0; ai < 2; ++ai)
#pragma unroll
            for (int m = 0; m < 4; ++m)
#pragma unroll
                for (int bj = 0; bj < 2; ++bj) {
                    float* dst = P + (size_t)(row0 + ai * 128 + m * 16) * 512 + col0 + bj * 128;
                    *(f32x4*)dst = acc[ai][bj][m][0]; *(f32x4*)(dst + 4) = acc[ai][bj][m][1];
                }
    }
};
struct CmpOrder {
    int G, c;
    DI bool next(int i, pg8::Unit& u) const { const long L = (long)i * G + c; if (L >= 32) return false; u.pm = (int)(L >> 1); u.pn = (int)(L & 1) + 2 * (u.pm >> 3); return true; }
    DI void a_ready(const pg8::Unit&) const {}
    DI void done(const pg8::Unit&) const {}
};

struct EpiOut {
    static constexpr bool PERM = true, AFTER_DRAIN = false;
    const float* x; const float* ga1; float* out; bf16_t* X1b; float* rss2;
    DI void operator()(const f32x4 (&acc)[2][2][4][2], const pg8::Unit& u, int wr, int wc, int fr, int fq) const {
        const int row0 = u.pm * 256 + wr * 64 + fr, col0 = u.pn * 256 + wc * 32 + 8 * fq;
        f32x4 gv[2][2];
#pragma unroll
        for (int bj = 0; bj < 2; ++bj)
#pragma unroll
            for (int n = 0; n < 2; ++n) gv[bj][n] = *(const f32x4*)(ga1 + col0 + bj * 128 + 4 * n);
#pragma unroll
        for (int ai = 0; ai < 2; ++ai)
#pragma unroll
            for (int m = 0; m < 4; ++m) {
                const int row = row0 + ai * 128 + m * 16; float s = 0.f;
#pragma unroll
                for (int bj = 0; bj < 2; ++bj) {
                    const size_t off = (size_t)row * DM + col0 + bj * 128;
                    const f32x4 x0 = *(const f32x4*)(x + off), x1 = *(const f32x4*)(x + off + 4);
                    const f32x4 v0 = x0 + gv[bj][0] * acc[ai][bj][m][0], v1 = x1 + gv[bj][1] * acc[ai][bj][m][1];
                    *(f32x4*)(out + off) = v0; *(f32x4*)(out + off + 4) = v1;
                    *(u32x4*)(X1b + off) = pack8(v0, v1);
                    s += (v0[0] * v0[0] + v0[1] * v0[1]) + (v0[2] * v0[2] + v0[3] * v0[3]) + (v1[0] * v1[0] + v1[1] * v1[1]) + (v1[2] * v1[2] + v1[3] * v1[3]);
                }
                s += __shfl_xor(s, 16); s += __shfl_xor(s, 32);
                if (fq == 0) atomicAdd(rss2 + row, s);
            }
    }
};

struct EpiFF1 {
    static constexpr bool PERM = true, AFTER_DRAIN = false;
    const float* rss2; const float* bias; bf16_t* H;
    DI void operator()(const f32x4 (&acc)[2][2][4][2], const pg8::Unit& u, int wr, int wc, int fr, int fq) const {
        const int row0 = u.pm * 256 + wr * 64 + fr, col0 = u.pn * 256 + wc * 32 + 8 * fq;
        f32x4 bv[2][2];
#pragma unroll
        for (int bj = 0; bj < 2; ++bj)
#pragma unroll
            for (int n = 0; n < 2; ++n) bv[bj][n] = *(const f32x4*)(bias + col0 + bj * 128 + 4 * n);
#pragma unroll
        for (int ai = 0; ai < 2; ++ai)
#pragma unroll
            for (int m = 0; m < 4; ++m) {
                const int row = row0 + ai * 128 + m * 16;
                const float rs = rsqrtf(rss2[row] * (1.f / DM) + EPS);
#pragma unroll
                for (int bj = 0; bj < 2; ++bj) {
                    f32x4 v0 = acc[ai][bj][m][0] * rs + bv[bj][0], v1 = acc[ai][bj][m][1] * rs + bv[bj][1];
#pragma unroll
                    for (int i = 0; i < 4; ++i) { const float a = fmaxf(v0[i], 0.f), b = fmaxf(v1[i], 0.f); v0[i] = a * a; v1[i] = b * b; }
                    *(u32x4*)(H + (size_t)row * FF + col0 + bj * 128) = pack8(v0, v1);
                }
            }
    }
};

struct EpiFF2 {
    static constexpr bool PERM = true, AFTER_DRAIN = false;
    const float* ga2; float* out;
    DI void operator()(const f32x4 (&acc)[2][2][4][2], const pg8::Unit& u, int wr, int wc, int fr, int fq) const {
        const int row0 = u.pm * 256 + wr * 64 + fr, col0 = u.pn * 256 + wc * 32 + 8 * fq;
        f32x4 gv[2][2];
#pragma unroll
        for (int bj = 0; bj < 2; ++bj)
#pragma unroll
            for (int n = 0; n < 2; ++n) gv[bj][n] = *(const f32x4*)(ga2 + col0 + bj * 128 + 4 * n);
#pragma unroll
        for (int ai = 0; ai < 2; ++ai)
#pragma unroll
            for (int m = 0; m < 4; ++m)
#pragma unroll
                for (int bj = 0; bj < 2; ++bj) {
                    float* dst = out + (size_t)(row0 + ai * 128 + m * 16) * DM + col0 + bj * 128;
                    const f32x4 x0 = *(const f32x4*)dst, x1 = *(const f32x4*)(dst + 4);
                    *(f32x4*)dst = x0 + gv[bj][0] * acc[ai][bj][m][0]; *(f32x4*)(dst + 4) = x1 + gv[bj][1] * acc[ai][bj][m][1];
                }
    }
};

DI void pooled_phase(const Params& p, int tid, int G) {
    const bf16_t* U = (const bf16_t*)(p.ws + WS_U);
    bf16_t* A2 = (bf16_t*)(p.ws + WS_A2);
    const int nb = G - 32;
    for (int idx = (blockIdx.x - 32) * 512 + tid; idx < SEQ * 64; idx += nb * 512) {
        const int t = idx >> 6, c8 = idx & 63, gi = c8 >> 4, w = 2 << gi;
        const int lo = (t + 1 - w) > 0 ? (t + 1 - w) : 0;
        float s[8];
#pragma unroll
        for (int i = 0; i < 8; ++i) s[i] = 0.f;
        for (int tt = lo; tt <= t; ++tt) {
            const u32x4 v = *(const u32x4*)(U + (size_t)tt * 512 + c8 * 8);
            s[0] += __uint_as_float(v.x << 16); s[1] += __uint_as_float(v.x & 0xffff0000u); s[2] += __uint_as_float(v.y << 16); s[3] += __uint_as_float(v.y & 0xffff0000u);
            s[4] += __uint_as_float(v.z << 16); s[5] += __uint_as_float(v.z & 0xffff0000u); s[6] += __uint_as_float(v.w << 16); s[7] += __uint_as_float(v.w & 0xffff0000u);
        }
        const float inv = 1.f / (float)(t + 1 - lo);
        const u32x4 v = *(const u32x4*)(U + (size_t)t * 512 + c8 * 8);
        float r[8];
        r[0] = s[0] * inv - __uint_as_float(v.x << 16); r[1] = s[1] * inv - __uint_as_float(v.x & 0xffff0000u);
        r[2] = s[2] * inv - __uint_as_float(v.y << 16); r[3] = s[3] * inv - __uint_as_float(v.y & 0xffff0000u);
        r[4] = s[4] * inv - __uint_as_float(v.z << 16); r[5] = s[5] * inv - __uint_as_float(v.z & 0xffff0000u);
        r[6] = s[6] * inv - __uint_as_float(v.w << 16); r[7] = s[7] * inv - __uint_as_float(v.w & 0xffff0000u);
        u32x4 o; o.x = pk2(r[0], r[1]); o.y = pk2(r[2], r[3]); o.z = pk2(r[4], r[5]); o.w = pk2(r[6], r[7]);
        *(u32x4*)(A2 + (size_t)t * DM + c8 * 8) = o;
    }
}

DI void phase4(const Params& p, LAS unsigned char* lds, int lane, int wave, int G) {
    unsigned char* ws = p.ws;
    const float* P = (const float*)(ws + WS_PCMP);
    const float* biasc = (const float*)(ws + WS_BIASC);
    LAS float* hb = (LAS float*)(lds + wave * 1024);
    const int gw = blockIdx.x * 8 + wave, NGW = G * 8;
    for (int r = gw; r < 4 * 1023; r += NGW) {
        const int kvg = r / 1023, n = r - kvg * 1023, kv = kvg >> 1, g = kvg & 1;
        const float* p0 = P + (size_t)(kvg * 1024 + n) * 512;
#pragma unroll
        for (int i = 0; i < 4; ++i) {
            const int j = lane + 64 * i;
            const float x = p0[j] + p0[512 + 256 + j] + biasc[kv * 256 + j];
            const float t = tanhf(0.7978845608028654f * (x + 0.044715f * x * x * x));
            hb[j] = 0.5f * x * (1.f + t);
        }
        LDS_WAIT();
        const float* w2 = p.in[kv ? I_W2V : I_W2K];
        float o = p.in[kv ? I_B2V : I_B2K][lane];
#pragma unroll 8
        for (int j = 0; j < 256; ++j) o += hb[j] * w2[j * 64 + lane];
        if (kv == 0) {
            const float ss = wave_sum(o * o);
            const float y = o * rsqrtf(ss * (1.f / 64.f) + EPS) * p.in[I_KCG][lane];
            ((bf16_t*)(ws + WS_KCMP))[((size_t)g * 1024 + n) * 64 + lane] = (bf16_t)(pk2(y, 0.f) & 0xffffu);
        } else {
            ((bf16_t*)(ws + WS_VCMPT))[(((size_t)g * 32 + (n >> 5)) * 64 + lane) * 32 + (n & 31)] = (bf16_t)(pk2(o, 0.f) & 0xffffu);
        }
        LDS_WAIT();
    }
}

#define MFMA16(a, b, c) __builtin_amdgcn_mfma_f32_16x16x32_bf16((a), (b), (c), 0, 0, 0)

DI void qk_tile(const bf16_t* kbase, const bf16x8 (&qf)[4][2], f32x4 (&s)[4][2], int tl, int quad) {
    bf16x8 kf[2][2];
#pragma unroll
    for (int ks = 0; ks < 2; ++ks)
#pragma unroll
        for (int dh = 0; dh < 2; ++dh) kf[ks][dh] = *(const bf16x8*)(kbase + (ks * 16 + tl) * 64 + dh * 32 + quad * 8);
#pragma unroll
    for (int h = 0; h < 4; ++h)
#pragma unroll
        for (int ks = 0; ks < 2; ++ks) {
            f32x4 z = {0.f, 0.f, 0.f, 0.f};
            z = MFMA16(kf[ks][0], qf[h][0], z);
            s[h][ks] = MFMA16(kf[ks][1], qf[h][1], z);
        }
}
DI void pv_tile(const bf16_t* vt, const bf16x8 (&pb)[4], f32x4 (&o)[4][4], int tl, int quad) {
#pragma unroll
    for (int dt = 0; dt < 4; ++dt) {
        const u32x2 a = *(const u32x2*)(vt + (dt * 16 + tl) * 32 + 4 * quad);
        const u32x2 b = *(const u32x2*)(vt + (dt * 16 + tl) * 32 + 16 + 4 * quad);
        u32x4 w; w.x = a.x; w.y = a.y; w.z = b.x; w.w = b.y;
        const bf16x8 vf = __builtin_bit_cast(bf16x8, w);
#pragma unroll
        for (int h = 0; h < 4; ++h) o[h][dt] = MFMA16(vf, pb[h], o[h][dt]);
    }
}
template <int STRIDE>
DI void exp_tile(f32x4 (&s)[4][2], const float (&sl2)[4], float ref2, int dbase, unsigned lim) {
    float fd[2][4]; bool ok[2][4];
#pragma unroll
    for (int ks = 0; ks < 2; ++ks)
#pragma unroll
        for (int i = 0; i < 4; ++i) { const int dist = dbase - STRIDE * (16 * ks + i); fd[ks][i] = (float)dist; ok[ks][i] = (unsigned)dist < lim; }
#pragma unroll
    for (int h = 0; h < 4; ++h) {
        const float nsl = -sl2[h];
#pragma unroll
        for (int ks = 0; ks < 2; ++ks)
#pragma unroll
            for (int i = 0; i < 4; ++i) {
                const float x = fmaf(nsl, fd[ks][i], fmaf(s[h][ks][i], C2, -ref2));
                const float e = __builtin_amdgcn_exp2f(x);
                s[h][ks][i] = ok[ks][i] ? e : 0.f;
            }
    }
}
DI void pack_tile(const f32x4 (&s)[4][2], bf16x8 (&pb)[4]) {
#pragma unroll
    for (int h = 0; h < 4; ++h) pb[h] = __builtin_bit_cast(bf16x8, pack8(s[h][0], s[h][1]));
}
DI void list_insert(unsigned (&lst)[16], unsigned key) {
#pragma unroll
    for (int i = 0; i < 16; ++i) { const unsigned hi = lst[i] > key ? lst[i] : key, lo = lst[i] > key ? key : lst[i]; lst[i] = hi; key = lo; }
}

DI void attn_unit(const Params& p, int tile, int g, int lane, LAS unsigned char* wl, float ref_c, float ref_s, float ref_w) {
    unsigned char* ws = p.ws;
    const int t0 = tile * 16, tl = lane & 15, quad = lane >> 4, tok = t0 + tl, cur = t0 >> 6;
    LAS f32x4* fin = (LAS f32x4*)wl;
    LAS unsigned* lstx = (LAS unsigned*)wl;
    LAS unsigned* msk = (LAS unsigned*)(wl + 16384);
    LAS unsigned* uni = msk + 128;
    const bf16_t* Q = (const bf16_t*)(ws + WS_Q);
    const bf16_t* KC = (const bf16_t*)(ws + WS_KCMP) + (size_t)g * 1024 * 64;
    const bf16_t* VCT = (const bf16_t*)(ws + WS_VCMPT) + (size_t)g * 32 * 64 * 32;
    const bf16_t* KS = (const bf16_t*)(ws + WS_KS) + (size_t)g * SEQ * 64;
    const bf16_t* VST = (const bf16_t*)(ws + WS_VST) + (size_t)g * 512 * 64 * 32;
    const bf16_t* KW = (const bf16_t*)(ws + WS_KW) + (size_t)g * SEQ * 64;
    const bf16_t* VWT = (const bf16_t*)(ws + WS_VWT) + (size_t)g * 512 * 64 * 32;
    const float* gate = (const float*)(ws + WS_G) + (size_t)tok * 24 + g * 12;

    bf16x8 qf[4][2];
#pragma unroll
    for (int h = 0; h < 4; ++h)
#pragma unroll
        for (int dh = 0; dh < 2; ++dh) qf[h][dh] = *(const bf16x8*)(Q + (size_t)tok * 512 + (g * 4 + h) * 64 + dh * 32 + quad * 8);
    float sl2[4];
#pragma unroll
    for (int h = 0; h < 4; ++h) sl2[h] = exp2f(-(float)(g * 4 + h + 1)) * LOG2E;

    f32x4 s[4][2]; f32x4 o[4][4]; bf16x8 pb[4]; float l[4];
    const int NT = (cur >> 3) + 1;
    const int dc0 = tok - 31 - 64 * quad;
#pragma unroll
    for (int h = 0; h < 4; ++h) l[h] = 0.f;
    for (int T = 0; T < NT; ++T) {
        qk_tile(KC + (size_t)T * 32 * 64, qf, s, tl, quad);
        exp_tile<16>(s, sl2, ref_c, dc0 - 512 * T, 0x80000000u);
#pragma unroll
        for (int h = 0; h < 4; ++h) l[h] += (s[h][0][0] + s[h][0][1]) + (s[h][0][2] + s[h][0][3]) + (s[h][1][0] + s[h][1][1]) + (s[h][1][2] + s[h][1][3]);
    }
    float inv[4];
#pragma unroll
    for (int h = 0; h < 4; ++h) { float L = l[h]; L += __shfl_xor(L, 16); L += __shfl_xor(L, 32); inv[h] = L > 0.f ? 1.f / L : 0.f; }
#pragma unroll
    for (int h = 0; h < 4; ++h)
#pragma unroll
        for (int dt = 0; dt < 4; ++dt) o[h][dt] = (f32x4){0.f, 0.f, 0.f, 0.f};
    unsigned lst[16];
#pragma unroll
    for (int i = 0; i < 16; ++i) lst[i] = 0u;
    float carry = 0.f;
    for (int T = 0; T < NT; ++T) {
        qk_tile(KC + (size_t)T * 32 * 64, qf, s, tl, quad);
        exp_tile<16>(s, sl2, ref_c, dc0 - 512 * T, 0x80000000u);
        float a0 = 0.f, a1 = 0.f, b0 = 0.f, b1 = 0.f;
#pragma unroll
        for (int h = 0; h < 4; ++h) {
            s[h][0] = s[h][0] * inv[h]; s[h][1] = s[h][1] * inv[h];
            a0 += (s[h][0][0] + s[h][0][1]) + (s[h][0][2] + 0.5f * s[h][0][3]); b0 += 0.5f * s[h][0][3];
            a1 += (s[h][1][0] + s[h][1][1]) + (s[h][1][2] + 0.5f * s[h][1][3]); b1 += 0.5f * s[h][1][3];
        }
        pack_tile(s, pb);
        pv_tile(VCT + (size_t)T * 64 * 32, pb, o, tl, quad);
        const float bs0 = __shfl(b0, (lane + 48) & 63), bs1 = __shfl(b1, (lane + 48) & 63);
        const float imp0 = a0 + (quad ? bs0 : carry), imp1 = a1 + (quad ? bs1 : bs0);
        carry = bs1;
        const int j0 = 8 * T + quad, j1 = j0 + 4;
        {
            const bool forced = (j0 == 0) || (j0 == cur) || (j0 == cur - 1);
            unsigned key = forced ? 0x7F000000u : (__float_as_uint(imp0) & 0xFFFFFE00u);
            key = (j0 <= cur) ? (key | 0x100u | (unsigned)(255 - j0)) : 0u;
            list_insert(lst, key);
        }
        {
            const bool forced = (j1 == 0) || (j1 == cur) || (j1 == cur - 1);
            unsigned key = forced ? 0x7F000000u : (__float_as_uint(imp1) & 0xFFFFFE00u);
            key = (j1 <= cur) ? (key | 0x100u | (unsigned)(255 - j1)) : 0u;
            list_insert(lst, key);
        }
    }
#pragma unroll
    for (int i = 0; i < 16; ++i) lstx[(tl * 4 + quad) * 16 + i] = lst[i];
    LDS_WAIT();
    if (quad == 0) {
        for (int qq = 1; qq < 4; ++qq) {
#pragma unroll
            for (int i = 0; i < 16; ++i) list_insert(lst, lstx[(tl * 4 + qq) * 16 + i]);
        }
        unsigned mw[8];
#pragma unroll
        for (int w = 0; w < 8; ++w) mw[w] = 0u;
#pragma unroll
        for (int i = 0; i < 16; ++i) {
            const unsigned key = lst[i]; const int j = 255 - (int)(key & 0xFFu); const unsigned bit = key ? (1u << (j & 31)) : 0u;
#pragma unroll
            for (int w = 0; w < 8; ++w) mw[w] |= ((j >> 5) == w) ? bit : 0u;
        }
#pragma unroll
        for (int w = 0; w < 8; ++w) msk[tl * 8 + w] = mw[w];
    }
    LDS_WAIT();
    if (lane < 8) {
        unsigned u = 0u;
#pragma unroll
        for (int tk = 0; tk < 16; ++tk) u |= msk[tk * 8 + lane];
        uni[lane] = u;
    }
    LDS_WAIT();
#pragma unroll
    for (int h = 0; h < 4; ++h) {
        const float gc = gate[h * 3 + 0];
#pragma unroll
        for (int dt = 0; dt < 4; ++dt) fin[(h * 4 + dt) * 64 + lane] = o[h][dt] * gc;
    }
#pragma unroll
    for (int h = 0; h < 4; ++h) {
        l[h] = 0.f;
#pragma unroll
        for (int dt = 0; dt < 4; ++dt) o[h][dt] = (f32x4){0.f, 0.f, 0.f, 0.f};
    }
    for (int w = 0; w < 8; ++w) {
        unsigned uw = (unsigned)__builtin_amdgcn_readfirstlane((int)uni[w]);
        const unsigned mym = msk[tl * 8 + w];
        while (uw) {
            const int b = __builtin_ctz(uw); uw &= uw - 1u;
            const int j = w * 32 + b;
            const unsigned lim = ((mym >> b) & 1u) ? 0x80000000u : 0u;
#pragma unroll 1
            for (int half = 0; half < 2; ++half) {
                const int kb = j * 64 + half * 32;
                qk_tile(KS + (size_t)kb * 64, qf, s, tl, quad);
                exp_tile<1>(s, sl2, ref_s, tok - kb - 4 * quad, lim);
#pragma unroll
                for (int h = 0; h < 4; ++h) l[h] += (s[h][0][0] + s[h][0][1]) + (s[h][0][2] + s[h][0][3]) + (s[h][1][0] + s[h][1][1]) + (s[h][1][2] + s[h][1][3]);
                pack_tile(s, pb);
                pv_tile(VST + (size_t)(kb >> 5) * 64 * 32, pb, o, tl, quad);
            }
        }
    }
#pragma unroll
    for (int h = 0; h < 4; ++h) {
        float L = l[h]; L += __shfl_xor(L, 16); L += __shfl_xor(L, 32);
        const float wgt = gate[h * 3 + 1] / L;
#pragma unroll
        for (int dt = 0; dt < 4; ++dt) fin[(h * 4 + dt) * 64 + lane] = fin[(h * 4 + dt) * 64 + lane] + o[h][dt] * wgt;
    }
#pragma unroll
    for (int h = 0; h < 4; ++h) {
        l[h] = 0.f;
#pragma unroll
        for (int dt = 0; dt < 4; ++dt) o[h][dt] = (f32x4){0.f, 0.f, 0.f, 0.f};
    }
    {
        const int kb0 = (t0 - 512) > 0 ? ((t0 - 512) & ~31) : 0, kbl = t0 & ~31;
        for (int kb = kb0; kb <= kbl; kb += 32) {
            qk_tile(KW + (size_t)kb * 64, qf, s, tl, quad);
            exp_tile<1>(s, sl2, ref_w, tok - kb - 4 * quad, 512u);
#pragma unroll
            for (int h = 0; h < 4; ++h) l[h] += (s[h][0][0] + s[h][0][1]) + (s[h][0][2] + s[h][0][3]) + (s[h][1][0] + s[h][1][1]) + (s[h][1][2] + s[h][1][3]);
            pack_tile(s, pb);
            pv_tile(VWT + (size_t)(kb >> 5) * 64 * 32, pb, o, tl, quad);
        }
    }
    bf16_t* dst = (bf16_t*)(ws + WS_A2) + (size_t)tok * DM + 512 + g * 256 + 4 * quad;
#pragma unroll
    for (int h = 0; h < 4; ++h) {
        float L = l[h]; L += __shfl_xor(L, 16); L += __shfl_xor(L, 32);
        const float wgt = gate[h * 3 + 2] / L;
#pragma unroll
        for (int dt = 0; dt < 4; ++dt) {
            const f32x4 v = fin[(h * 4 + dt) * 64 + lane] + o[h][dt] * wgt;
            u32x2 w; w.x = pk2(v[0], v[1]); w.y = pk2(v[2], v[3]);
            *(u32x2*)(dst + h * 64 + dt * 16) = w;
        }
    }
    LDS_WAIT();
}

DI void attn_phase(const Params& p, LAS unsigned char* lds, int lane, int wave, int G) {
    LAS unsigned char* wl = lds + wave * WAVE_LDS;
    const float gq = wave_max(fabsf(p.in[I_QG][lane]));
    const float ref_c = C2 * 64.f * gq * wave_max(fabsf(p.in[I_KCG][lane]));
    const float ref_s = C2 * 64.f * gq * wave_max(fabsf(p.in[I_KSG][lane]));
    const float ref_w = C2 * 64.f * gq * wave_max(fabsf(p.in[I_KWG][lane]));
    const int sd = wave & 3, hh = wave >> 2;
    for (int pp = blockIdx.x * 4 + sd; pp < 1024; pp += G * 4) {
        const int tp = pp >> 1, g = pp & 1;
        const int tile = hh ? (1023 - tp) : tp;
        attn_unit(p, tile, g, lane, wl, ref_c, ref_s, ref_w);
    }
}

template <bool COOP, int ONLY>
__global__ void __launch_bounds__(512, 2) mega(Params p) {
    extern __shared__ __attribute__((aligned(16))) unsigned char lds_raw[];
    LAS unsigned char* lds = (LAS unsigned char*)lds_raw;
    const int tid = threadIdx.x, lane = tid & 63, wave = __builtin_amdgcn_readfirstlane(tid >> 6), G = gridDim.x;
    unsigned char* ws = p.ws;
    const int lo = p.ph_lo, hi = p.ph_hi;
#define IN(k) ((ONLY < 0 || ONLY == (k)) && lo <= (k) && (k) < hi)
#define SEAM(k) do { if (COOP && IN(k) && IN((k) + 1)) { __threadfence(); cg::this_grid().sync(); } } while (0)
    if (IN(0)) phase0(p, lds, tid, lane, wave, G);
    SEAM(0);
    if (IN(1)) phase1(p, lds, tid, lane, wave, G);
    SEAM(1);
    if (IN(2)) {
        pg8::Gemm g{(const bf16_t*)(ws + WS_XB), (const bf16_t*)(ws + WS_WINT), SEQ, NIN, DM};
        pg8::StaticOrder S; S.init(SEQ, NIN, G, (int)blockIdx.x);
        EpiIn E{(const float*)(ws + WS_RSTD1), (const float*)(ws + WS_BIASIN), p.in[I_QG], p.in[I_KSG], p.in[I_KWG],
                (bf16_t*)(ws + WS_U), (bf16_t*)(ws + WS_Q), (bf16_t*)(ws + WS_ACMP), (bf16_t*)(ws + WS_KS), (bf16_t*)(ws + WS_KW), (bf16_t*)(ws + WS_VST), (bf16_t*)(ws + WS_VWT),
                (float*)(ws + WS_G), (LAS float*)(lds + XCH_OFF)};
        pg8::gemm_phase<EpiIn, pg8::StaticOrder, true, true>(lds, g, S, E);
    }
    SEAM(2);
    if (IN(3)) {
        if (blockIdx.x < 32) {
            pg8::Gemm g{(const bf16_t*)(ws + WS_ACMP), (const bf16_t*)(ws + WS_W1CT), 4096, 1024, 1024};
            CmpOrder S{G, (int)blockIdx.x};
            EpiCmp E{(float*)(ws + WS_PCMP)};
            pg8::gemm_phase<EpiCmp, CmpOrder, true, true>(lds, g, S, E);
        } else pooled_phase(p, tid, G);
    }
    SEAM(3);
    if (IN(4)) phase4(p, lds, lane, wave, G);
    SEAM(4);
    if (IN(5)) attn_phase(p, lds, lane, wave, G);
    SEAM(5);
    if (IN(6)) {
        __syncthreads();
        pg8::Gemm g{(const bf16_t*)(ws + WS_A2), (const bf16_t*)(ws + WS_WOUTT), SEQ, DM, DM};
        pg8::StaticOrder S; S.init(SEQ, DM, G, (int)blockIdx.x);
        EpiOut E{p.in[I_X], (const float*)(ws + WS_MOD) + 2 * DM, p.out, (bf16_t*)(ws + WS_XB), (float*)(ws + WS_RSS2)};
        pg8::gemm_phase<EpiOut, pg8::StaticOrder, true, true>(lds, g, S, E);
    }
    SEAM(6);
    if (IN(7)) {
        pg8::Gemm g{(const bf16_t*)(ws + WS_XB), (const bf16_t*)(ws + WS_WFF1T), SEQ, FF, DM};
        pg8::StaticOrder S; S.init(SEQ, FF, G, (int)blockIdx.x);
        EpiFF1 E{(const float*)(ws + WS_RSS2), (const float*)(ws + WS_BIASFF), (bf16_t*)(ws + WS_H)};
        pg8::gemm_phase<EpiFF1, pg8::StaticOrder, true, true>(lds, g, S, E);
    }
    SEAM(7);
    if (IN(8)) {
        pg8::Gemm g{(const bf16_t*)(ws + WS_H), (const bf16_t*)(ws + WS_WFF2T), SEQ, DM, FF};
        pg8::StaticOrder S; S.init(SEQ, DM, G, (int)blockIdx.x);
        EpiFF2 E{(const float*)(ws + WS_MOD) + 5 * DM, p.out};
        pg8::gemm_phase<EpiFF2, pg8::StaticOrder, true, true>(lds, g, S, E);
    }
#undef IN
#undef SEAM
}

#ifndef N_LAUNCH_MODE
#define N_LAUNCH_MODE 1
#endif
#if N_LAUNCH_MODE == 1
#define QUERY_KERNEL mega<true, -1>
#else
#define QUERY_KERNEL mega<false, 2>
template <int K> static void launch_phase(int grid, Params p, hipStream_t stream) {
    p.ph_lo = K; p.ph_hi = K + 1;
    (void)hipFuncSetAttribute((const void*)mega<false, K>, hipFuncAttributeMaxDynamicSharedMemorySize, LDS_BYTES);
    hipLaunchKernelGGL((mega<false, K>), dim3(grid), dim3(512), LDS_BYTES, stream, p);
}
#endif
extern "C" void kernel_launch(void* const* d_in, const int* in_sizes, int n_in, void* d_out, int out_size, void* d_ws, size_t ws_size, hipStream_t stream) {
    static int grid = 0;
    if (grid == 0) {
        if (n_in != 26 || out_size != SEQ * DM || ws_size < WS_END) { fprintf(stderr, "kernel_launch: unexpected problem shape (n_in %d out %d ws %zu)\n", n_in, out_size, ws_size); grid = -1; return; }
        int dev = 0, cus = 0, per_cu = 0;
        (void)hipGetDevice(&dev);
        (void)hipDeviceGetAttribute(&cus, hipDeviceAttributeMultiprocessorCount, dev);
        (void)hipFuncSetAttribute((const void*)QUERY_KERNEL, hipFuncAttributeMaxDynamicSharedMemorySize, LDS_BYTES);
        (void)hipOccupancyMaxActiveBlocksPerMultiprocessor(&per_cu, (const void*)QUERY_KERNEL, 512, LDS_BYTES);
        if (per_cu < 1) { fprintf(stderr, "kernel_launch: occupancy query says %d blocks/CU\n", per_cu); per_cu = 1; }
        grid = cus;
        (void)hipGetLastError();
    }
    if (grid < 0) return;
    Params p{};
    for (int i = 0; i < 26; ++i) p.in[i] = (const float*)d_in[i];
    p.out = (float*)d_out; p.ws = (unsigned char*)d_ws;
#if N_LAUNCH_MODE == 1
    p.ph_lo = 0; p.ph_hi = 9;
    void* args[] = {&p};
    hipError_t e = hipLaunchCooperativeKernel((const void*)mega<true, -1>, dim3(grid), dim3(512), args, LDS_BYTES, stream);
    if (e != hipSuccess) fprintf(stderr, "cooperative launch failed: %s (grid %d)\n", hipGetErrorString(e), grid);
#else
    launch_phase<0>(grid, p, stream); launch_phase<1>(grid, p, stream); launch_phase<2>(grid, p, stream);
    launch_phase<3>(grid, p, stream); launch_phase<4>(grid, p, stream); launch_phase<5>(grid, p, stream);
    launch_phase<6>(grid, p, stream); launch_phase<7>(grid, p, stream); launch_phase<8>(grid, p, stream);
#endif
}
```

```cpp
#include <hip/hip_runtime.h>
#include <hip/hip_cooperative_groups.h>
#include <cstdio>
#include <cstdint>
namespace cg = cooperative_groups;
namespace pg8 {
#define PG8_LAS __attribute__((address_space(3)))
typedef unsigned short bf16_t;
typedef short bf16x8 __attribute__((ext_vector_type(8)));
typedef float f32x4 __attribute__((ext_vector_type(4)));
typedef unsigned u32x4 __attribute__((ext_vector_type(4)));
constexpr int BM = 256, BK = 64, HALF = 128, HTB = HALF * BK * 2  , STAGE_BYTES = 8 * HTB, NXCD = 8, WGM = 8;

__host__ __device__ __forceinline__ int lds_byte(int r, int c) { const int st = (r >> 4) * 2 + (c >> 5), rr = r & 15, cc = c & 31, ob = rr * 64 + cc * 2; return st * 1024 + (ob ^ (((ob >> 9) & 1) << 5)); }
__host__ __device__ __forceinline__ void stage_rc(int b, int& R, int& C) { const int st = b / 1024, sb = b % 1024, swz = sb ^ (((sb >> 9) & 1) << 5); R = (st >> 1) * 16 + swz / 64; C = (st & 1) * 32 + (swz % 64) / 2; }
__host__ __device__ __forceinline__ int perm32(int rho) { const int n = rho >> 4, i = rho & 15; return 8 * (i >> 2) + 4 * n + (i & 3); }

struct Unit { int pm, pn; };
struct Gemm { const bf16_t* A; const bf16_t* Bt; int M, N, K; };

struct StaticOrder {
    int nM, nN, nwg, G, c;
    __host__ __device__ void init(int M, int N, int G_, int c_) { nM = M / BM; nN = N / BM; nwg = nM * nN; G = G_; c = c_; }
    __host__ __device__ bool next(int i, Unit& u) const {
        const long L = (long)i * G + c; if (L >= nwg) return false;
        int wgid = (int)L; { const int q = nwg / NXCD, r = nwg % NXCD, xcd = wgid % NXCD, off = wgid / NXCD; wgid = (xcd < r ? xcd * (q + 1) : r * (q + 1) + (xcd - r) * q) + off; }
        const int nig = WGM * nN, gid = wgid / nig, fm = gid * WGM, gsz = (nM - fm) < WGM ? (nM - fm) : WGM;
        u.pm = fm + ((wgid % nig) % gsz); u.pn = (wgid % nig) / gsz; return true;
    }
    __device__ __forceinline__ void a_ready(const Unit&) const {}
    __device__ __forceinline__ void done(const Unit&) const {}
};

__device__ __forceinline__ unsigned cvt_pk_bf16(float lo, float hi) { unsigned r; asm volatile("v_cvt_pk_bf16_f32 %0, %1, %2" : "=v"(r) : "v"(lo), "v"(hi)); return r; }
template <class Epi, class Sched, bool ALIGN_EPI = false, bool SP2 = false>
__device__ __forceinline__ void gemm_phase(PG8_LAS unsigned char* lds, const Gemm g, const Sched& S, const Epi& E) {
    const int tid = threadIdx.x, wid = __builtin_amdgcn_readfirstlane(tid >> 6), lane = tid & 63, wr = wid >> 2, wc = wid & 3, fr = lane & 15, fq = lane >> 4;
    const int K = g.K, nt = K / BK;
    unsigned voffA[2], voffB[2];
#pragma unroll
    for (int i = 0; i < 2; ++i) { int R, C; stage_rc(tid * 16 + i * 8192, R, C); const int Rb = Epi::PERM ? ((R & ~31) + perm32(R & 31)) : R;
        voffA[i] = (unsigned)(R * K + C) * 2u; voffB[i] = (unsigned)(Rb * K + C) * 2u; }
    const size_t kstep = (size_t)(BK * 2);
    const size_t hstep = (size_t)HALF * K * 2;
    const size_t tstep = 2 * hstep;
    const unsigned ldsw = (unsigned)wid * 1024u;
    const int aoff = lds_byte(wr * 64 + fr, fq * 8), boff = lds_byte(wc * 32 + fr, fq * 8);
#define PG8_SA(b, h) (((b) * 2 + (h)) * HTB)
#define PG8_SB(b, h) ((4 + (b) * 2 + (h)) * HTB)
#define PG8_STAGE(bufoff, gbase, voff) do { _Pragma("unroll") for (int _i = 0; _i < 2; ++_i) \
        __builtin_amdgcn_global_load_lds((const unsigned*)((const char*)(gbase) + (voff)[_i]), (PG8_LAS unsigned*)(lds + (bufoff) + ldsw + _i * 8192), 16, 0, 0); } while (0)
#define PG8_LDA(dst, b, h) do { _Pragma("unroll") for (int m = 0; m < 4; ++m) _Pragma("unroll") for (int k = 0; k < 2; ++k) dst[m][k] = *(const PG8_LAS bf16x8*)(lds + PG8_SA(b, h) + aoff + m * 2048 + k * 1024); } while (0)
#define PG8_LDB(dst, b, h) do { _Pragma("unroll") for (int n = 0; n < 2; ++n) _Pragma("unroll") for (int k = 0; k < 2; ++k) dst[n][k] = *(const PG8_LAS bf16x8*)(lds + PG8_SB(b, h) + boff + n * 2048 + k * 1024); } while (0)
#define PG8_MMA(ai, bj, At, Bt) do { __builtin_amdgcn_s_setprio(1); _Pragma("unroll") for (int m = 0; m < 4; ++m) _Pragma("unroll") for (int n = 0; n < 2; ++n) _Pragma("unroll") for (int k = 0; k < 2; ++k) \
        acc[ai][bj][m][n] = __builtin_amdgcn_mfma_f32_16x16x32_bf16(Bt[n][k], At[m][k], acc[ai][bj][m][n], 0, 0, 0); __builtin_amdgcn_s_setprio(0); } while (0)
#define PG8_WAIT_V(n) asm volatile("s_waitcnt vmcnt(" #n ")" ::: "memory")
#define PG8_WAIT_L(n) asm volatile("s_waitcnt lgkmcnt(" #n ")" ::: "memory")
#define PG8_BAR __builtin_amdgcn_s_barrier()
#define PG8_SCHED __builtin_amdgcn_sched_barrier(0)
    Unit cur, nxt; int ui = 0;
    if (!S.next(0, cur)) return;
    f32x4 acc[2][2][4][2];
#pragma unroll
    for (int a = 0; a < 2; ++a)
#pragma unroll
        for (int b = 0; b < 2; ++b)
#pragma unroll
            for (int m = 0; m < 4; ++m)
#pragma unroll
                for (int n = 0; n < 2; ++n) acc[a][b][m][n] = (f32x4){0.f, 0.f, 0.f, 0.f};
    bf16x8 At[4][2], B0[2][2], B1[2][2];
    const char* cA = (const char*)g.A + (size_t)cur.pm * tstep; const char* cB = (const char*)g.Bt + (size_t)cur.pn * tstep;
    S.a_ready(cur);
    if constexpr (SP2) {
        PG8_STAGE(PG8_SB(0, 0), cB, voffB); PG8_STAGE(PG8_SB(0, 1), cB + hstep, voffB); PG8_STAGE(PG8_SA(0, 0), cA, voffA); PG8_STAGE(PG8_SA(0, 1), cA + hstep, voffA);
        if (wr == 1) PG8_BAR;
        PG8_WAIT_V(2); PG8_BAR;
        PG8_STAGE(PG8_SB(1, 0), cB + kstep, voffB); PG8_STAGE(PG8_SA(1, 0), cA + kstep, voffA); PG8_STAGE(PG8_SB(1, 1), cB + hstep + kstep, voffB);
        PG8_WAIT_V(6); PG8_BAR;
    } else {
        PG8_STAGE(PG8_SB(0, 0), cB, voffB); PG8_STAGE(PG8_SA(0, 0), cA, voffA); PG8_STAGE(PG8_SB(0, 1), cB + hstep, voffB); PG8_STAGE(PG8_SA(0, 1), cA + hstep, voffA);
        if (wr == 1) PG8_BAR;
        PG8_WAIT_V(4); PG8_BAR;
        PG8_STAGE(PG8_SB(1, 0), cB + kstep, voffB); PG8_STAGE(PG8_SA(1, 0), cA + kstep, voffA); PG8_STAGE(PG8_SB(1, 1), cB + hstep + kstep, voffB);
        PG8_WAIT_V(6); PG8_BAR;
    }
    for (;;) {
        const bool has_next = S.next(ui + 1, nxt);
        const char* nA = has_next ? (const char*)g.A + (size_t)nxt.pm * tstep : cA; const char* nB = has_next ? (const char*)g.Bt + (size_t)nxt.pn * tstep : cB;
        for (int t = 0; t < nt; t += 2) {
            const bool last = (t == nt - 2);
            const char* a1 = cA + (size_t)(t + 1) * kstep;
            const char* a2 = last ? nA : cA + (size_t)(t + 2) * kstep; const char* b2 = last ? nB : cB + (size_t)(t + 2) * kstep;
            const char* a3 = a2 + kstep; const char* b3 = b2 + kstep;
            if (last && has_next) S.a_ready(nxt);
            if constexpr (SP2) {
            PG8_LDB(B0, 0, 0); PG8_LDB(B1, 0, 1); PG8_SCHED; PG8_LDA(At, 0, 0); PG8_STAGE(PG8_SA(1, 1), a1 + hstep, voffA);
            PG8_WAIT_V(8); PG8_WAIT_L(0); PG8_BAR; PG8_MMA(0, 0, At, B0); PG8_MMA(0, 1, At, B1); PG8_BAR; PG8_SCHED;
            PG8_LDA(At, 0, 1); PG8_STAGE(PG8_SB(0, 0), b2, voffB); PG8_STAGE(PG8_SB(0, 1), b2 + hstep, voffB); PG8_STAGE(PG8_SA(0, 0), a2, voffA);
            PG8_WAIT_V(8); PG8_WAIT_L(0); PG8_BAR; PG8_MMA(1, 0, At, B0); PG8_MMA(1, 1, At, B1); PG8_BAR; PG8_SCHED;
            PG8_LDB(B0, 1, 0); PG8_LDB(B1, 1, 1); PG8_SCHED; PG8_LDA(At, 1, 0); PG8_STAGE(PG8_SA(0, 1), a2 + hstep, voffA);
            PG8_WAIT_V(8); PG8_WAIT_L(0); PG8_BAR; PG8_MMA(0, 0, At, B0); PG8_MMA(0, 1, At, B1); PG8_BAR; PG8_SCHED;
            PG8_LDA(At, 1, 1); PG8_STAGE(PG8_SB(1, 0), b3, voffB); PG8_STAGE(PG8_SB(1, 1), b3 + hstep, voffB); PG8_STAGE(PG8_SA(1, 0), a3, voffA);
            PG8_WAIT_V(8); PG8_WAIT_L(0); PG8_BAR; PG8_MMA(1, 0, At, B0); PG8_MMA(1, 1, At, B1); PG8_BAR; PG8_SCHED;
            } else {
            PG8_LDB(B0, 0, 0); PG8_SCHED; PG8_LDA(At, 0, 0); PG8_STAGE(PG8_SA(1, 1), a1 + hstep, voffA);
            PG8_WAIT_L(8); PG8_BAR; PG8_WAIT_L(0); PG8_MMA(0, 0, At, B0); PG8_BAR; PG8_SCHED;
            PG8_LDB(B1, 0, 1); PG8_STAGE(PG8_SB(0, 0), b2, voffB);
            PG8_BAR; PG8_WAIT_L(0); PG8_MMA(0, 1, At, B1); PG8_BAR;
            PG8_LDA(At, 0, 1); PG8_STAGE(PG8_SA(0, 0), a2, voffA);
            PG8_BAR; PG8_WAIT_L(0); PG8_MMA(1, 0, At, B0); PG8_BAR; PG8_SCHED;
            PG8_STAGE(PG8_SB(0, 1), b2 + hstep, voffB);
            PG8_WAIT_V(6); PG8_BAR; PG8_MMA(1, 1, At, B1); PG8_BAR;
            PG8_LDB(B0, 1, 0); PG8_SCHED; PG8_LDA(At, 1, 0); PG8_STAGE(PG8_SA(0, 1), a2 + hstep, voffA);
            PG8_WAIT_L(8); PG8_BAR; PG8_WAIT_L(0); PG8_MMA(0, 0, At, B0); PG8_BAR; PG8_SCHED;
            PG8_LDB(B1, 1, 1); PG8_STAGE(PG8_SB(1, 0), b3, voffB);
            PG8_BAR; PG8_WAIT_L(0); PG8_MMA(0, 1, At, B1); PG8_BAR;
            PG8_LDA(At, 1, 1); PG8_STAGE(PG8_SA(1, 0), a3, voffA);
            PG8_BAR; PG8_WAIT_L(0); PG8_MMA(1, 0, At, B0); PG8_BAR; PG8_SCHED;
            PG8_STAGE(PG8_SB(1, 1), b3 + hstep, voffB);
            PG8_WAIT_V(6); PG8_BAR; PG8_MMA(1, 1, At, B1); PG8_BAR;
            }
        }
        if constexpr (ALIGN_EPI) { if (wr == 0) PG8_BAR; }
        if constexpr (!Epi::AFTER_DRAIN) { E(acc, cur, wr, wc, fr, fq); S.done(cur); }
        if (!has_next) break;
#pragma unroll
        for (int a = 0; a < 2; ++a)
#pragma unroll
            for (int b = 0; b < 2; ++b)
#pragma unroll
                for (int m = 0; m < 4; ++m)
#pragma unroll
                    for (int n = 0; n < 2; ++n) acc[a][b][m][n] = (f32x4){0.f, 0.f, 0.f, 0.f};
        cur = nxt; cA = nA; cB = nB; ++ui;
        if constexpr (ALIGN_EPI) { if (wr == 1) PG8_BAR; }
    }
    PG8_WAIT_V(0);
    if constexpr (!ALIGN_EPI) { if (wr == 0) PG8_BAR; }
    PG8_BAR;
    if constexpr (Epi::AFTER_DRAIN) { E.fused(acc, cur, wr, wc, fr, fq, lds, wid, lane); S.done(cur); }
#undef PG8_SA
#undef PG8_SB
#undef PG8_STAGE
#undef PG8_LDA
#undef PG8_LDB
#undef PG8_MMA
#undef PG8_WAIT_V
#undef PG8_WAIT_L
#undef PG8_BAR
#undef PG8_SCHED
}
}

using pg8::bf16_t; using pg8::bf16x8; using pg8::f32x4; using pg8::u32x4;
#define LAS __attribute__((address_space(3)))
#define DI __device__ __forceinline__
#define LDS_WAIT() asm volatile("s_waitcnt lgkmcnt(0)" ::: "memory")
typedef unsigned u32x2 __attribute__((ext_vector_type(2)));

constexpr int SEQ = 16384, DM = 1024, NIN = 2048, INW = 1816, FF = 4096;
constexpr float EPS = 1e-6f;
constexpr float LOG2E = 1.4426950408889634f;
constexpr float C2 = 0.125f * LOG2E;
constexpr size_t MiB = 1u << 20;
constexpr size_t WS_MOD = 1 * MiB;
constexpr size_t WS_BIASIN = WS_MOD + 32768;
constexpr size_t WS_BIASFF = WS_BIASIN + 8192;
constexpr size_t WS_BIASC = WS_BIASFF + 16384;
constexpr size_t WS_RSTD1 = WS_BIASC + 2048;
constexpr size_t WS_RSS2 = WS_RSTD1 + 65536;
constexpr size_t WS_G = 2 * MiB;
constexpr size_t WS_KCMP = 4 * MiB;
constexpr size_t WS_VCMPT = 4 * MiB + 262144;
constexpr size_t WS_WINT = 5 * MiB;
constexpr size_t WS_WOUTT = 9 * MiB;
constexpr size_t WS_WFF1T = 11 * MiB;
constexpr size_t WS_WFF2T = 19 * MiB;
constexpr size_t WS_W1CT = 27 * MiB;
constexpr size_t WS_PCMP = 29 * MiB;
constexpr size_t WS_XB = 40 * MiB;
constexpr size_t WS_H = 72 * MiB;
constexpr size_t WS_U = 72 * MiB;
constexpr size_t WS_Q = 88 * MiB;
constexpr size_t WS_ACMP = 104 * MiB;
constexpr size_t WS_KS = 112 * MiB;
constexpr size_t WS_KW = 116 * MiB;
constexpr size_t WS_VST = 120 * MiB;
constexpr size_t WS_VWT = 124 * MiB;
constexpr size_t WS_A2 = 128 * MiB;
constexpr size_t WS_END = 200 * MiB;
constexpr int LDS_BYTES = 147456;
constexpr int XCH_OFF = 131072;
constexpr int WAVE_LDS = 17408;

struct Params {
    const float* in[26];
    float* out;
    unsigned char* ws;
    int ph_lo, ph_hi;
};
enum { I_X = 0, I_C, I_WADA, I_BADA, I_N1G, I_N2G, I_WIN, I_WPOOL, I_PSCALE, I_QG, I_KCG, I_KSG, I_KWG,
       I_POSK, I_W1K, I_B1K, I_W2K, I_B2K, I_POSV, I_W1V, I_B1V, I_W2V, I_B2V, I_WOUT, I_WFF1, I_WFF2 };

DI unsigned pk2(float lo, float hi) { return pg8::cvt_pk_bf16(lo, hi); }
DI float bf2f(unsigned short h) { return __uint_as_float((unsigned)h << 16); }
DI float wave_sum(float v) {
#pragma unroll
    for (int o = 1; o < 64; o <<= 1) v += __shfl_xor(v, o);
    return v;
}
DI float wave_max(float v) {
#pragma unroll
    for (int o = 1; o < 64; o <<= 1) v = fmaxf(v, __shfl_xor(v, o));
    return v;
}

DI void gemv_item(const float* v, const float* W, int ldw, int K, int j0, int nvalid, const float* bias, float* out, LAS float* red, int tid) {
    const int c = tid & 31, kp = tid >> 5, j = j0 + c;
    float s = 0.f;
    if (j < nvalid) {
#pragma unroll 8
        for (int k = kp; k < K; k += 16) s += v[k] * W[(size_t)k * ldw + j];
    }
    red[kp * 32 + c] = s;
    __syncthreads();
    if (tid < 32) {
        float t = 0.f;
#pragma unroll
        for (int i = 0; i < 16; ++i) t += red[i * 32 + tid];
        if (j0 + tid < nvalid) out[j0 + tid] = t + (bias ? bias[j0 + tid] : 0.f);
    }
    __syncthreads();
}

DI void transpose_item(const float* W, int ldw, int k0, int n0, int nvalid, const float* sg, const float* sm, bf16_t* WT, int ldt, int row_off, int col_off, LAS float* scr, int lane) {
#pragma unroll 8
    for (int i = 0; i < 32; ++i) {
        const int kk = 2 * i + (lane >> 5), n = n0 + (lane & 31);
        float v = (n < nvalid) ? W[(size_t)(k0 + kk) * ldw + n] : 0.f;
        if (sg) v *= sg[k0 + kk] * (1.f + sm[k0 + kk]);
        scr[kk * 33 + (lane & 31)] = v;
    }
    LDS_WAIT();
    const int c = lane & 7;
#pragma unroll
    for (int j = 0; j < 4; ++j) {
        const int n = (lane >> 3) + 8 * j; const LAS float* s = scr + (8 * c) * 33 + n;
        u32x4 o; o.x = pk2(s[0 * 33], s[1 * 33]); o.y = pk2(s[2 * 33], s[3 * 33]); o.z = pk2(s[4 * 33], s[5 * 33]); o.w = pk2(s[6 * 33], s[7 * 33]);
        *(u32x4*)(WT + (size_t)(row_off + n0 + n) * ldt + col_off + k0 + 8 * c) = o;
    }
    LDS_WAIT();
}

DI void phase0(const Params& p, LAS unsigned char* lds, int tid, int lane, int wave, int G) {
    unsigned char* ws = p.ws;
    float* mod = (float*)(ws + WS_MOD);
    LAS float* red = (LAS float*)(lds + XCH_OFF);
    for (int it = blockIdx.x; it < 192 + 16; it += G) {
        if (it < 192) gemv_item(p.in[I_C], p.in[I_WADA], 6 * DM, DM, it * 32, 6 * DM, p.in[I_BADA], mod, red, tid);
        else { const int r = it - 192, kv = r >> 3, j0 = (r & 7) * 32;
            gemv_item(p.in[kv ? I_POSV : I_POSK], p.in[kv ? I_W1V : I_W1K], 256, 2048, j0, 256, p.in[kv ? I_B1V : I_B1K], (float*)(ws + WS_BIASC) + kv * 256, red, tid); }
    }
    LAS float* scr = (LAS float*)(lds + wave * 16384);
    const int gw = blockIdx.x * 8 + wave, NGW = G * 8;
    constexpr int N_ROWS = SEQ, N_TO = 8 * 32, N_T2 = 64 * 32, N_TC = 4 * 128, N_WC = 512, N_Z1 = 512, N_Z2 = 64;
    constexpr int NITEMS = N_ROWS + N_TO + N_T2 + N_TC + N_WC + N_Z1 + N_Z2;
    for (int it = gw; it < NITEMS; it += NGW) {
        int r = it;
        if (r < N_ROWS) {
            const f32x4* xr = (const f32x4*)(p.in[I_X] + (size_t)r * DM) + lane;
            f32x4 v[4]; float s = 0.f;
#pragma unroll
            for (int j = 0; j < 4; ++j) { v[j] = xr[64 * j]; s += (v[j].x * v[j].x + v[j].y * v[j].y) + (v[j].z * v[j].z + v[j].w * v[j].w); }
            s = wave_sum(s);
            if (lane == 0) ((float*)(ws + WS_RSTD1))[r] = rsqrtf(s * (1.f / DM) + EPS);
            u32x2* o8 = (u32x2*)((bf16_t*)(ws + WS_XB) + (size_t)r * DM) + lane;
#pragma unroll
            for (int j = 0; j < 4; ++j) { u32x2 o; o.x = pk2(v[j].x, v[j].y); o.y = pk2(v[j].z, v[j].w); o8[64 * j] = o; }
            continue;
        }
        r -= N_ROWS;
        if (r < N_TO) {
            transpose_item(p.in[I_WOUT] + (size_t)512 * DM, DM, (r >> 5) * 64, (r & 31) * 32, DM, nullptr, nullptr, (bf16_t*)(ws + WS_WOUTT), DM, 0, 512, scr, lane);
            continue;
        }
        r -= N_TO;
        if (r < N_T2) {
            transpose_item(p.in[I_WFF2], DM, (r >> 5) * 64, (r & 31) * 32, DM, nullptr, nullptr, (bf16_t*)(ws + WS_WFF2T), FF, 0, 0, scr, lane);
            continue;
        }
        r -= N_T2;
        if (r < N_TC) {
            const int piece = r >> 7, q = r & 127, kv = piece >> 1, half = piece & 1;
            transpose_item(p.in[kv ? I_W1V : I_W1K] + (size_t)half * 1024 * 256, 256, (q >> 3) * 64, (q & 7) * 32, 256, nullptr, nullptr, (bf16_t*)(ws + WS_W1CT), 1024, piece * 256, 0, scr, lane);
            continue;
        }
        r -= N_TC;
        if (r < N_WC) {
            const int g = r >> 7, nt = (r >> 3) & 15, cc = r & 7, n = nt * 64 + lane;
            const float* wp = p.in[I_WPOOL] + (size_t)(g * 128 + cc * 16) * 128;
            const float* ps = p.in[I_PSCALE] + g * 128;
            const float* wo = p.in[I_WOUT] + (size_t)(g * 128) * DM + n;
            float acc[16];
#pragma unroll
            for (int i = 0; i < 16; ++i) acc[i] = 0.f;
            for (int d = 0; d < 128; ++d) {
                const float z = ps[d] * wo[(size_t)d * DM];
#pragma unroll
                for (int i = 0; i < 16; ++i) acc[i] += wp[i * 128 + d] * z;
            }
            u32x4 o0, o1;
            o0.x = pk2(acc[0], acc[1]); o0.y = pk2(acc[2], acc[3]); o0.z = pk2(acc[4], acc[5]); o0.w = pk2(acc[6], acc[7]);
            o1.x = pk2(acc[8], acc[9]); o1.y = pk2(acc[10], acc[11]); o1.z = pk2(acc[12], acc[13]); o1.w = pk2(acc[14], acc[15]);
            bf16_t* dst = (bf16_t*)(ws + WS_WOUTT) + (size_t)n * DM + g * 128 + cc * 16;
            *(u32x4*)dst = o0; *(u32x4*)(dst + 8) = o1;
            continue;
        }
        r -= N_WC;
        if (r < N_Z1) { u32x4 z = {0u, 0u, 0u, 0u}; *((u32x4*)(ws + WS_KCMP) + (size_t)r * 64 + lane) = z; continue; }
        r -= N_Z1;
        { u32x4 z = {0u, 0u, 0u, 0u}; *((u32x4*)(ws + WS_RSS2) + (size_t)r * 64 + lane) = z; }
    }
}

DI void phase1(const Params& p, LAS unsigned char* lds, int tid, int lane, int wave, int G) {
    unsigned char* ws = p.ws;
    const float* mod = (const float*)(ws + WS_MOD);
    LAS float* red = (LAS float*)(lds + XCH_OFF);
    for (int it = blockIdx.x; it < 57 + 128; it += G) {
        if (it < 57) gemv_item(mod + 0, p.in[I_WIN], INW, DM, it * 32, INW, nullptr, (float*)(ws + WS_BIASIN), red, tid);
        else gemv_item(mod + 3 * DM, p.in[I_WFF1], FF, DM, (it - 57) * 32, FF, nullptr, (float*)(ws + WS_BIASFF), red, tid);
    }
    LAS float* scr = (LAS float*)(lds + wave * 16384);
    const int gw = blockIdx.x * 8 + wave, NGW = G * 8;
    constexpr int N_TI = 16 * 57, N_T1 = 16 * 128;
    for (int it = gw; it < N_TI + N_T1; it += NGW) {
        if (it < N_TI) transpose_item(p.in[I_WIN], INW, (it / 57) * 64, (it % 57) * 32, INW, p.in[I_N1G], mod + 1 * DM, (bf16_t*)(ws + WS_WINT), DM, 0, 0, scr, lane);
        else { const int r = it - N_TI; transpose_item(p.in[I_WFF1], FF, (r >> 7) * 64, (r & 127) * 32, FF, p.in[I_N2G], mod + 4 * DM, (bf16_t*)(ws + WS_WFF1T), DM, 0, 0, scr, lane); }
    }
}
#define XB_TMO      128
#define XB_XCNT(j)  (256  + 64 * (j))
#define XB_XSUB(j)  (1280 + 64 * (j))
#define XB_XGEN(j)  (2304 + 64 * (j))
#define XB_TOP      3328
#define XB_TOPGEN   3392
#define XCD_BAR_WORDS 3456
#define XB_SPIN_CAP (1u << 18)

__device__ __forceinline__ unsigned xb_ld(unsigned* p)              { return __hip_atomic_load(p, __ATOMIC_RELAXED, __HIP_MEMORY_SCOPE_AGENT); }
__device__ __forceinline__ unsigned xb_add(unsigned* p, unsigned v) { return __hip_atomic_fetch_add(p, v, __ATOMIC_RELAXED, __HIP_MEMORY_SCOPE_AGENT); }
__device__ __forceinline__ unsigned xb_xcc_id() { return (unsigned)__builtin_amdgcn_s_getreg((3 << 11) | 20) & 0xFu; }
#define XB_SPIN(cond, bar) do { unsigned _sp = 0; while (cond) { __builtin_amdgcn_s_sleep(1); \
    if ((++_sp & 255u) == 0u) { if (xb_ld(&(bar)[XB_TMO])) break; if (_sp > XB_SPIN_CAP) { atomicAdd(&(bar)[XB_TMO], 1u); break; } } } } while (0)

struct XcdBarrier {
    unsigned* bar; unsigned x;
    volatile LAS unsigned* st;
};

__device__ __forceinline__ XcdBarrier xcd_barrier_post(unsigned* bar, volatile LAS unsigned* st) {
    XcdBarrier b; b.bar = bar; b.x = xb_xcc_id(); b.st = st;
    if (threadIdx.x == 0) (void)xb_add(&bar[XB_XCNT(b.x)], 1u);
    return b;
}
__device__ __forceinline__ void xcd_barrier_complete(unsigned* bar, unsigned x, unsigned& nloc, unsigned& nx) {
    const unsigned G = gridDim.x * gridDim.y * gridDim.z;
    unsigned sum, cnt, mine, sp = 0u;
    for (;;) {
        sum = 0u; cnt = 0u; mine = 0u;
#pragma unroll
        for (unsigned j = 0; j < 16; ++j) { const unsigned c = xb_ld(&bar[XB_XCNT(j)]); sum += c; cnt += (c > 0u) ? 1u : 0u; mine = (j == x) ? c : mine; }
        if (sum == G) break;
        __builtin_amdgcn_s_sleep(1);
        if ((++sp & 255u) == 0u) { if (xb_ld(&bar[XB_TMO])) break; if (sp > XB_SPIN_CAP) { atomicAdd(&bar[XB_TMO], 1u); break; } }
    }
    nloc = mine > 0u ? mine : 1u; nx = cnt > 0u ? cnt : 1u;
}

__device__ __forceinline__ void xcd_barrier(const XcdBarrier& b) {
    asm volatile("s_waitcnt vmcnt(0)" ::: "memory");
    __syncthreads();
    if (threadIdx.x == 0) {
        unsigned* bar = b.bar;
        __builtin_amdgcn_s_waitcnt(0);
        unsigned nloc = b.st[0], nx = b.st[1];
        if (nloc == 0u) { xcd_barrier_complete(bar, b.x, nloc, nx); b.st[0] = nloc; b.st[1] = nx; }
        const unsigned old = xb_add(&bar[XB_XSUB(b.x)], 1u);
        const unsigned gen = old / nloc;
        if (old + 1u == (gen + 1u) * nloc) {
            __builtin_amdgcn_fence(__ATOMIC_RELEASE, "agent");
            asm volatile("s_waitcnt vmcnt(0)" ::: "memory");
            const unsigned og = xb_add(&bar[XB_TOP], 1u);
            const unsigned tg = og / nx;
            if (og + 1u == (tg + 1u) * nx) xb_add(&bar[XB_TOPGEN], 1u);
            else XB_SPIN(xb_ld(&bar[XB_TOPGEN]) == tg, bar);
            __builtin_amdgcn_fence(__ATOMIC_ACQUIRE, "agent");
            xb_add(&bar[XB_XGEN(b.x)], 1u);
            asm volatile("s_waitcnt vmcnt(0)" ::: "memory");
        } else {
            XB_SPIN(xb_ld(&bar[XB_XGEN(b.x)]) == gen, bar);
            __builtin_amdgcn_fence(__ATOMIC_ACQUIRE, "agent");
            asm volatile("s_waitcnt vmcnt(0)" ::: "memory");
        }
    }
    __syncthreads();
}

DI u32x4 pack8(const f32x4& a, const f32x4& b) { u32x4 w; w.x = pk2(a[0], a[1]); w.y = pk2(a[2], a[3]); w.z = pk2(b[0], b[1]); w.w = pk2(b[2], b[3]); return w; }

struct EpiIn {
    static constexpr bool PERM = true, AFTER_DRAIN = false;
    const float* rstd1; const float* bias; const float* q_gain; const float* ks_gain; const float* kw_gain;
    bf16_t *U, *Q, *ACMP, *KS, *KW, *VST, *VWT; float* G; LAS float* xch;
    DI void operator()(const f32x4 (&acc)[2][2][4][2], const pg8::Unit& u, int wr, int wc, int fr, int fq_in) const {
        const int pn = u.pn, wid = wr * 4 + wc;
        int fq = fq_in; asm volatile("" : "+v"(fq));
        int row0 = u.pm * 256 + wr * 64 + fr, colb = pn * 256 + wc * 32 + 8 * fq;
        asm volatile("" : "+v"(row0), "+v"(colb));
        const int gsel = wc >> 1, d0 = (wc & 1) * 32 + 8 * fq;
#pragma unroll
        for (int bj = 0; bj < 2; ++bj) {
            float ss[2][4];
#pragma unroll
            for (int ai = 0; ai < 2; ++ai)
#pragma unroll
                for (int m = 0; m < 4; ++m) {
                    const float rsv = rstd1[row0 + ai * 128 + m * 16];
                    const f32x4 v0 = acc[ai][bj][m][0] * rsv + *(const f32x4*)(bias + colb + bj * 128), v1 = acc[ai][bj][m][1] * rsv + *(const f32x4*)(bias + colb + bj * 128 + 4);
                    float s = (v0[0] * v0[0] + v0[1] * v0[1]) + (v0[2] * v0[2] + v0[3] * v0[3]) + (v1[0] * v1[0] + v1[1] * v1[1]) + (v1[2] * v1[2] + v1[3] * v1[3]);
                    s += __shfl_xor(s, 16); s += __shfl_xor(s, 32);
                    ss[ai][m] = s;
                }
            if (fq == 0) {
#pragma unroll
                for (int ai = 0; ai < 2; ++ai)
#pragma unroll
                    for (int m = 0; m < 4; ++m) xch[wid * 256 + ((bj * 2 + ai) * 4 + m) * 16 + fr] = ss[ai][m];
            }
            LDS_WAIT(); __builtin_amdgcn_s_barrier(); asm volatile("" ::: "memory");
#pragma unroll
            for (int ai = 0; ai < 2; ++ai)
#pragma unroll
                for (int m = 0; m < 4; ++m) ss[ai][m] += xch[(wid ^ 1) * 256 + ((bj * 2 + ai) * 4 + m) * 16 + fr];
#pragma unroll
            for (int ai = 0; ai < 2; ++ai)
#pragma unroll
                for (int m = 0; m < 4; ++m) {
                    const int row = row0 + ai * 128 + m * 16;
                    const float rsv = rstd1[row];
                    f32x4 v0 = acc[ai][bj][m][0] * rsv + *(const f32x4*)(bias + colb + bj * 128), v1 = acc[ai][bj][m][1] * rsv + *(const f32x4*)(bias + colb + bj * 128 + 4);
                    if (pn < 2) {
                        *(u32x4*)(U + (size_t)row * 512 + pn * 256 + bj * 128 + wc * 32 + 8 * fq) = pack8(v0, v1);
                    } else if (pn < 4) {
                        const float rn = rsqrtf(ss[ai][m] * (1.f / 64.f) + EPS);
                        const f32x4 g0 = *(const f32x4*)(q_gain + d0), g1 = *(const f32x4*)(q_gain + d0 + 4);
                        v0 = v0 * rn * g0; v1 = v1 * rn * g1;
                        *(u32x4*)(Q + (size_t)row * 512 + (pn - 2) * 256 + bj * 128 + wc * 32 + 8 * fq) = pack8(v0, v1);
                    } else if (pn == 4) {
                        *(u32x4*)(ACMP + ((size_t)(bj * 2 + gsel) * SEQ + row) * 64 + d0) = pack8(v0, v1);
                    } else if (pn < 7) {
                        if (bj == 0) {
                            const float* gain = (pn == 5) ? ks_gain : kw_gain;
                            const float rn = rsqrtf(ss[ai][m] * (1.f / 64.f) + EPS);
                            const f32x4 g0 = *(const f32x4*)(gain + d0), g1 = *(const f32x4*)(gain + d0 + 4);
                            v0 = v0 * rn * g0; v1 = v1 * rn * g1;
                            bf16_t* K = (pn == 5) ? KS : KW;
                            *(u32x4*)(K + ((size_t)gsel * SEQ + row) * 64 + d0) = pack8(v0, v1);
                        } else {
                            bf16_t* VT = ((pn == 5) ? VST : VWT) + (((size_t)gsel * 512 + (row >> 5)) * 64 + d0) * 32 + (row & 31);
                            const u32x4 w = pack8(v0, v1);
                            VT[0 * 32] = (bf16_t)(w.x & 0xffffu); VT[1 * 32] = (bf16_t)(w.x >> 16); VT[2 * 32] = (bf16_t)(w.y & 0xffffu); VT[3 * 32] = (bf16_t)(w.y >> 16);
                            VT[4 * 32] = (bf16_t)(w.z & 0xffffu); VT[5 * 32] = (bf16_t)(w.z >> 16); VT[6 * 32] = (bf16_t)(w.w & 0xffffu); VT[7 * 32] = (bf16_t)(w.w >> 16);
                        }
                    } else {
                        if (bj == 0 && wc == 0 && fq < 3) {
                            f32x4 s0, s1;
#pragma unroll
                            for (int i = 0; i < 4; ++i) { s0[i] = __builtin_amdgcn_rcpf(1.f + __expf(-v0[i])); s1[i] = __builtin_amdgcn_rcpf(1.f + __expf(-v1[i])); }
                            *(f32x4*)(G + (size_t)row * 24 + 8 * fq) = s0; *(f32x4*)(G + (size_t)row * 24 + 8 * fq + 4) = s1;
                        }
                    }
                }
        }
    }
};

struct EpiCmp {
    static constexpr bool PERM = true, AFTER_DRAIN = false;
    float* P;
    DI void operator()(const f32x4 (&acc)[2][2][4][2], const pg8::Unit& u, int wr, int wc, int fr, int fq) const {
        const int row0 = u.pm * 256 + wr * 64 + fr, col0 = (u.pn & 1) * 256 + wc * 32 + 8 * fq;
#pragma unroll
        for (int ai = 0; ai < 2; ++ai)
#pragma unroll
            for (int m = 0; m < 4; ++m)
#pragma unroll
                for (int bj = 0; bj < 2; ++bj) {
                    float* dst = P + (size_t)(row0 + ai * 128 + m * 16) * 512 + col0 + bj * 128;
                    *(f32x4*)dst = acc[ai][bj][m][0]; *(f32x4*)(dst + 4) = acc[ai][bj][m][1];
                }
    }
};
struct CmpOrder {
    int G, c;
    DI bool next(int i, pg8::Unit& u) const { const long L = (long)i * G + c; if (L >= 32) return false; u.pm = (int)(L >> 1); u.pn = (int)(L & 1) + 2 * (u.pm >> 3); return true; }
    DI void a_ready(const pg8::Unit&) const {}
    DI void done(const pg8::Unit&) const {}
};

struct EpiOut {
    static constexpr bool PERM = true, AFTER_DRAIN = false;
    const float* x; const float* ga1; float* out; bf16_t* X1b; float* rss2;
    DI void operator()(const f32x4 (&acc)[2][2][4][2], const pg8::Unit& u, int wr, int wc, int fr, int fq) const {
        const int row0 = u.pm * 256 + wr * 64 + fr, col0 = u.pn * 256 + wc * 32 + 8 * fq;
        f32x4 gv[2][2];
#pragma unroll
        for (int bj = 0; bj < 2; ++bj)
#pragma unroll
            for (int n = 0; n < 2; ++n) gv[bj][n] = *(const f32x4*)(ga1 + col0 + bj * 128 + 4 * n);
#pragma unroll
        for (int ai = 0; ai < 2; ++ai)
#pragma unroll
            for (int m = 0; m < 4; ++m) {
                const int row = row0 + ai * 128 + m * 16; float s = 0.f;
#pragma unroll
                for (int bj = 0; bj < 2; ++bj) {
                    const size_t off = (size_t)row * DM + col0 + bj * 128;
                    const f32x4 x0 = *(const f32x4*)(x + off), x1 = *(const f32x4*)(x + off + 4);
                    const f32x4 v0 = x0 + gv[bj][0] * acc[ai][bj][m][0], v1 = x1 + gv[bj][1] * acc[ai][bj][m][1];
                    *(f32x4*)(out + off) = v0; *(f32x4*)(out + off + 4) = v1;
                    *(u32x4*)(X1b + off) = pack8(v0, v1);
                    s += (v0[0] * v0[0] + v0[1] * v0[1]) + (v0[2] * v0[2] + v0[3] * v0[3]) + (v1[0] * v1[0] + v1[1] * v1[1]) + (v1[2] * v1[2] + v1[3] * v1[3]);
                }
                s += __shfl_xor(s, 16); s += __shfl_xor(s, 32);
                if (fq == 0) atomicAdd(rss2 + row, s);
            }
    }
};

struct EpiFF1 {
    static constexpr bool PERM = true, AFTER_DRAIN = false;
    const float* rss2; const float* bias; bf16_t* H;
    DI void operator()(const f32x4 (&acc)[2][2][4][2], const pg8::Unit& u, int wr, int wc, int fr, int fq) const {
        const int row0 = u.pm * 256 + wr * 64 + fr, col0 = u.pn * 256 + wc * 32 + 8 * fq;
        f32x4 bv[2][2];
#pragma unroll
        for (int bj = 0; bj < 2; ++bj)
#pragma unroll
            for (int n = 0; n < 2; ++n) bv[bj][n] = *(const f32x4*)(bias + col0 + bj * 128 + 4 * n);
#pragma unroll
        for (int ai = 0; ai < 2; ++ai)
#pragma unroll
            for (int m = 0; m < 4; ++m) {
                const int row = row0 + ai * 128 + m * 16;
                const float rs = rsqrtf(rss2[row] * (1.f / DM) + EPS);
#pragma unroll
                for (int bj = 0; bj < 2; ++bj) {
                    f32x4 v0 = acc[ai][bj][m][0] * rs + bv[bj][0], v1 = acc[ai][bj][m][1] * rs + bv[bj][1];
#pragma unroll
                    for (int i = 0; i < 4; ++i) { const float a = fmaxf(v0[i], 0.f), b = fmaxf(v1[i], 0.f); v0[i] = a * a; v1[i] = b * b; }
                    *(u32x4*)(H + (size_t)row * FF + col0 + bj * 128) = pack8(v0, v1);
                }
            }
    }
};

struct EpiFF2 {
    static constexpr bool PERM = true, AFTER_DRAIN = false;
    const float* ga2; float* out;
    DI void operator()(const f32x4 (&acc)[2][2][4][2], const pg8::Unit& u, int wr, int wc, int fr, int fq) const {
        const int row0 = u.pm * 256 + wr * 64 + fr, col0 = u.pn * 256 + wc * 32 + 8 * fq;
        f32x4 gv[2][2];
#pragma unroll
        for (int bj = 0; bj < 2; ++bj)
#pragma unroll
            for (int n = 0; n < 2; ++n) gv[bj][n] = *(const f32x4*)(ga2 + col0 + bj * 128 + 4 * n);
#pragma unroll
        for (int ai = 0; ai < 2; ++ai)
#pragma unroll
            for (int m = 0; m < 4; ++m)
#pragma unroll
                for (int bj = 0; bj < 2; ++bj) {
                    float* dst = out + (size_t)(row0 + ai * 128 + m * 16) * DM + col0 + bj * 128;
                    const f32x4 x0 = *(const f32x4*)dst, x1 = *(const f32x4*)(dst + 4);
                    *(f32x4*)dst = x0 + gv[bj][0] * acc[ai][bj][m][0]; *(f32x4*)(dst + 4) = x1 + gv[bj][1] * acc[ai][bj][m][1];
                }
    }
};

DI void pooled_phase(const Params& p, int tid, int G) {
    const bf16_t* U = (const bf16_t*)(p.ws + WS_U);
    bf16_t* A2 = (bf16_t*)(p.ws + WS_A2);
    const int nb = G - 32;
    for (int idx = (blockIdx.x - 32) * 512 + tid; idx < SEQ * 64; idx += nb * 512) {
        const int t = idx >> 6, c8 = idx & 63, gi = c8 >> 4, w = 2 << gi;
        const int lo = (t + 1 - w) > 0 ? (t + 1 - w) : 0;
        float s[8];
#pragma unroll
        for (int i = 0; i < 8; ++i) s[i] = 0.f;
        for (int tt = lo; tt <= t; ++tt) {
            const u32x4 v = *(const u32x4*)(U + (size_t)tt * 512 + c8 * 8);
            s[0] += __uint_as_float(v.x << 16); s[1] += __uint_as_float(v.x & 0xffff0000u); s[2] += __uint_as_float(v.y << 16); s[3] += __uint_as_float(v.y & 0xffff0000u);
            s[4] += __uint_as_float(v.z << 16); s[5] += __uint_as_float(v.z & 0xffff0000u); s[6] += __uint_as_float(v.w << 16); s[7] += __uint_as_float(v.w & 0xffff0000u);
        }
        const float inv = 1.f / (float)(t + 1 - lo);
        const u32x4 v = *(const u32x4*)(U + (size_t)t * 512 + c8 * 8);
        float r[8];
        r[0] = s[0] * inv - __uint_as_float(v.x << 16); r[1] = s[1] * inv - __uint_as_float(v.x & 0xffff0000u);
        r[2] = s[2] * inv - __uint_as_float(v.y << 16); r[3] = s[3] * inv - __uint_as_float(v.y & 0xffff0000u);
        r[4] = s[4] * inv - __uint_as_float(v.z << 16); r[5] = s[5] * inv - __uint_as_float(v.z & 0xffff0000u);
        r[6] = s[6] * inv - __uint_as_float(v.w << 16); r[7] = s[7] * inv - __uint_as_float(v.w & 0xffff0000u);
        u32x4 o; o.x = pk2(r[0], r[1]); o.y = pk2(r[2], r[3]); o.z = pk2(r[4], r[5]); o.w = pk2(r[6], r[7]);
        *(u32x4*)(A2 + (size_t)t * DM + c8 * 8) = o;
    }
}

DI void phase4(const Params& p, LAS unsigned char* lds, int lane, int wave, int G) {
    unsigned char* ws = p.ws;
    const float* P = (const float*)(ws + WS_PCMP);
    const float* biasc = (const float*)(ws + WS_BIASC);
    LAS float* hb = (LAS float*)(lds + wave * 1024);
    const int gw = blockIdx.x * 8 + wave, NGW = G * 8;
    for (int r = gw; r < 4 * 1023; r += NGW) {
        const int kvg = r / 1023, n = r - kvg * 1023, kv = kvg >> 1, g = kvg & 1;
        const float* p0 = P + (size_t)(kvg * 1024 + n) * 512;
#pragma unroll
        for (int i = 0; i < 4; ++i) {
            const int j = lane + 64 * i;
            const float x = p0[j] + p0[512 + 256 + j] + biasc[kv * 256 + j];
            const float t = tanhf(0.7978845608028654f * (x + 0.044715f * x * x * x));
            hb[j] = 0.5f * x * (1.f + t);
        }
        LDS_WAIT();
        const float* w2 = p.in[kv ? I_W2V : I_W2K];
        float o = p.in[kv ? I_B2V : I_B2K][lane];
#pragma unroll 8
        for (int j = 0; j < 256; ++j) o += hb[j] * w2[j * 64 + lane];
        if (kv == 0) {
            const float ss = wave_sum(o * o);
            const float y = o * rsqrtf(ss * (1.f / 64.f) + EPS) * p.in[I_KCG][lane];
            ((bf16_t*)(ws + WS_KCMP))[((size_t)g * 1024 + n) * 64 + lane] = (bf16_t)(pk2(y, 0.f) & 0xffffu);
        } else {
            ((bf16_t*)(ws + WS_VCMPT))[(((size_t)g * 32 + (n >> 5)) * 64 + lane) * 32 + (n & 31)] = (bf16_t)(pk2(o, 0.f) & 0xffffu);
        }
        LDS_WAIT();
    }
}

#define MFMA16(a, b, c) __builtin_amdgcn_mfma_f32_16x16x32_bf16((a), (b), (c), 0, 0, 0)

DI void qk_tile(const bf16_t* kbase, const bf16x8 (&qf)[4][2], f32x4 (&s)[4][2], int tl, int quad) {
    bf16x8 kf[2][2];
#pragma unroll
    for (int ks = 0; ks < 2; ++ks)
#pragma unroll
        for (int dh = 0; dh < 2; ++dh) kf[ks][dh] = *(const bf16x8*)(kbase + (ks * 16 + tl) * 64 + dh * 32 + quad * 8);
#pragma unroll
    for (int h = 0; h < 4; ++h)
#pragma unroll
        for (int ks = 0; ks < 2; ++ks) {
            f32x4 z = {0.f, 0.f, 0.f, 0.f};
            z = MFMA16(kf[ks][0], qf[h][0], z);
            s[h][ks] = MFMA16(kf[ks][1], qf[h][1], z);
        }
}
DI void pv_tile(const bf16_t* vt, const bf16x8 (&pb)[4], f32x4 (&o)[4][4], int tl, int quad) {
#pragma unroll
    for (int dt = 0; dt < 4; ++dt) {
        const u32x2 a = *(const u32x2*)(vt + (dt * 16 + tl) * 32 + 4 * quad);
        const u32x2 b = *(const u32x2*)(vt + (dt * 16 + tl) * 32 + 16 + 4 * quad);
        u32x4 w; w.x = a.x; w.y = a.y; w.z = b.x; w.w = b.y;
        const bf16x8 vf = __builtin_bit_cast(bf16x8, w);
#pragma unroll
        for (int h = 0; h < 4; ++h) o[h][dt] = MFMA16(vf, pb[h], o[h][dt]);
    }
}
template <int STRIDE>
DI void exp_tile(f32x4 (&s)[4][2], const float (&sl2)[4], float ref2, int dbase, unsigned lim) {
    float fd[2][4]; bool ok[2][4];
#pragma unroll
    for (int ks = 0; ks < 2; ++ks)
#pragma unroll
        for (int i = 0; i < 4; ++i) { const int dist = dbase - STRIDE * (16 * ks + i); fd[ks][i] = (float)dist; ok[ks][i] = (unsigned)dist < lim; }
#pragma unroll
    for (int h = 0; h < 4; ++h) {
        const float nsl = -sl2[h];
#pragma unroll
        for (int ks = 0; ks < 2; ++ks)
#pragma unroll
            for (int i = 0; i < 4; ++i) {
                const float x = fmaf(nsl, fd[ks][i], fmaf(s[h][ks][i], C2, -ref2));
                const float e = __builtin_amdgcn_exp2f(x);
                s[h][ks][i] = ok[ks][i] ? e : 0.f;
            }
    }
}
DI void pack_tile(const f32x4 (&s)[4][2], bf16x8 (&pb)[4]) {
#pragma unroll
    for (int h = 0; h < 4; ++h) pb[h] = __builtin_bit_cast(bf16x8, pack8(s[h][0], s[h][1]));
}
DI void list_insert(unsigned (&lst)[16], unsigned key) {
#pragma unroll
    for (int i = 0; i < 16; ++i) { const unsigned hi = lst[i] > key ? lst[i] : key, lo = lst[i] > key ? key : lst[i]; lst[i] = hi; key = lo; }
}

DI void attn_unit(const Params& p, int tile, int g, int lane, LAS unsigned char* wl, float ref_c, float ref_s, float ref_w) {
    unsigned char* ws = p.ws;
    const int t0 = tile * 16, tl = lane & 15, quad = lane >> 4, tok = t0 + tl, cur = t0 >> 6;
    LAS f32x4* fin = (LAS f32x4*)wl;
    LAS unsigned* lstx = (LAS unsigned*)wl;
    LAS unsigned* msk = (LAS unsigned*)(wl + 16384);
    LAS unsigned* uni = msk + 128;
    const bf16_t* Q = (const bf16_t*)(ws + WS_Q);
    const bf16_t* KC = (const bf16_t*)(ws + WS_KCMP) + (size_t)g * 1024 * 64;
    const bf16_t* VCT = (const bf16_t*)(ws + WS_VCMPT) + (size_t)g * 32 * 64 * 32;
    const bf16_t* KS = (const bf16_t*)(ws + WS_KS) + (size_t)g * SEQ * 64;
    const bf16_t* VST = (const bf16_t*)(ws + WS_VST) + (size_t)g * 512 * 64 * 32;
    const bf16_t* KW = (const bf16_t*)(ws + WS_KW) + (size_t)g * SEQ * 64;
    const bf16_t* VWT = (const bf16_t*)(ws + WS_VWT) + (size_t)g * 512 * 64 * 32;
    const float* gate = (const float*)(ws + WS_G) + (size_t)tok * 24 + g * 12;

    bf16x8 qf[4][2];
#pragma unroll
    for (int h = 0; h < 4; ++h)
#pragma unroll
        for (int dh = 0; dh < 2; ++dh) qf[h][dh] = *(const bf16x8*)(Q + (size_t)tok * 512 + (g * 4 + h) * 64 + dh * 32 + quad * 8);
    float sl2[4];
#pragma unroll
    for (int h = 0; h < 4; ++h) sl2[h] = exp2f(-(float)(g * 4 + h + 1)) * LOG2E;

    f32x4 s[4][2]; f32x4 o[4][4]; bf16x8 pb[4]; float l[4];
    const int NT = (cur >> 3) + 1;
    const int dc0 = tok - 31 - 64 * quad;
#pragma unroll
    for (int h = 0; h < 4; ++h) l[h] = 0.f;
    for (int T = 0; T < NT; ++T) {
        qk_tile(KC + (size_t)T * 32 * 64, qf, s, tl, quad);
        exp_tile<16>(s, sl2, ref_c, dc0 - 512 * T, 0x80000000u);
#pragma unroll
        for (int h = 0; h < 4; ++h) l[h] += (s[h][0][0] + s[h][0][1]) + (s[h][0][2] + s[h][0][3]) + (s[h][1][0] + s[h][1][1]) + (s[h][1][2] + s[h][1][3]);
    }
    float inv[4];
#pragma unroll
    for (int h = 0; h < 4; ++h) { float L = l[h]; L += __shfl_xor(L, 16); L += __shfl_xor(L, 32); inv[h] = L > 0.f ? 1.f / L : 0.f; }
#pragma unroll
    for (int h = 0; h < 4; ++h)
#pragma unroll
        for (int dt = 0; dt < 4; ++dt) o[h][dt] = (f32x4){0.f, 0.f, 0.f, 0.f};
    unsigned lst[16];
#pragma unroll
    for (int i = 0; i < 16; ++i) lst[i] = 0u;
    float carry = 0.f;
    for (int T = 0; T < NT; ++T) {
        qk_tile(KC + (size_t)T * 32 * 64, qf, s, tl, quad);
        exp_tile<16>(s, sl2, ref_c, dc0 - 512 * T, 0x80000000u);
        float a0 = 0.f, a1 = 0.f, b0 = 0.f, b1 = 0.f;
#pragma unroll
        for (int h = 0; h < 4; ++h) {
            s[h][0] = s[h][0] * inv[h]; s[h][1] = s[h][1] * inv[h];
            a0 += (s[h][0][0] + s[h][0][1]) + (s[h][0][2] + 0.5f * s[h][0][3]); b0 += 0.5f * s[h][0][3];
            a1 += (s[h][1][0] + s[h][1][1]) + (s[h][1][2] + 0.5f * s[h][1][3]); b1 += 0.5f * s[h][1][3];
        }
        pack_tile(s, pb);
        pv_tile(VCT + (size_t)T * 64 * 32, pb, o, tl, quad);
        const float bs0 = __shfl(b0, (lane + 48) & 63), bs1 = __shfl(b1, (lane + 48) & 63);
        const float imp0 = a0 + (quad ? bs0 : carry), imp1 = a1 + (quad ? bs1 : bs0);
        carry = bs1;
        const int j0 = 8 * T + quad, j1 = j0 + 4;
        {
            const bool forced = (j0 == 0) || (j0 == cur) || (j0 == cur - 1);
            unsigned key = forced ? 0x7F000000u : (__float_as_uint(imp0) & 0xFFFFFE00u);
            key = (j0 <= cur) ? (key | 0x100u | (unsigned)(255 - j0)) : 0u;
            list_insert(lst, key);
        }
        {
            const bool forced = (j1 == 0) || (j1 == cur) || (j1 == cur - 1);
            unsigned key = forced ? 0x7F000000u : (__float_as_uint(imp1) & 0xFFFFFE00u);
            key = (j1 <= cur) ? (key | 0x100u | (unsigned)(255 - j1)) : 0u;
            list_insert(lst, key);
        }
    }
#pragma unroll
    for (int i = 0; i < 16; ++i) lstx[(tl * 4 + quad) * 16 + i] = lst[i];
    LDS_WAIT();
    if (quad == 0) {
        for (int qq = 1; qq < 4; ++qq) {
#pragma unroll
            for (int i = 0; i < 16; ++i) list_insert(lst, lstx[(tl * 4 + qq) * 16 + i]);
        }
        unsigned mw[8];
#pragma unroll
        for (int w = 0; w < 8; ++w) mw[w] = 0u;
#pragma unroll
        for (int i = 0; i < 16; ++i) {
            const unsigned key = lst[i]; const int j = 255 - (int)(key & 0xFFu); const unsigned bit = key ? (1u << (j & 31)) : 0u;
#pragma unroll
            for (int w = 0; w < 8; ++w) mw[w] |= ((j >> 5) == w) ? bit : 0u;
        }
#pragma unroll
        for (int w = 0; w < 8; ++w) msk[tl * 8 + w] = mw[w];
    }
    LDS_WAIT();
    if (lane < 8) {
        unsigned u = 0u;
#pragma unroll
        for (int tk = 0; tk < 16; ++tk) u |= msk[tk * 8 + lane];
        uni[lane] = u;
    }
    LDS_WAIT();
#pragma unroll
    for (int h = 0; h < 4; ++h) {
        const float gc = gate[h * 3 + 0];
#pragma unroll
        for (int dt = 0; dt < 4; ++dt) fin[(h * 4 + dt) * 64 + lane] = o[h][dt] * gc;
    }
#pragma unroll
    for (int h = 0; h < 4; ++h) {
        l[h] = 0.f;
#pragma unroll
        for (int dt = 0; dt < 4; ++dt) o[h][dt] = (f32x4){0.f, 0.f, 0.f, 0.f};
    }
    for (int w = 0; w < 8; ++w) {
        unsigned uw = (unsigned)__builtin_amdgcn_readfirstlane((int)uni[w]);
        const unsigned mym = msk[tl * 8 + w];
        while (uw) {
            const int b = __builtin_ctz(uw); uw &= uw - 1u;
            const int j = w * 32 + b;
            const unsigned lim = ((mym >> b) & 1u) ? 0x80000000u : 0u;
#pragma unroll 1
            for (int half = 0; half < 2; ++half) {
                const int kb = j * 64 + half * 32;
                qk_tile(KS + (size_t)kb * 64, qf, s, tl, quad);
                exp_tile<1>(s, sl2, ref_s, tok - kb - 4 * quad, lim);
#pragma unroll
                for (int h = 0; h < 4; ++h) l[h] += (s[h][0][0] + s[h][0][1]) + (s[h][0][2] + s[h][0][3]) + (s[h][1][0] + s[h][1][1]) + (s[h][1][2] + s[h][1][3]);
                pack_tile(s, pb);
                pv_tile(VST + (size_t)(kb >> 5) * 64 * 32, pb, o, tl, quad);
            }
        }
    }
#pragma unroll
    for (int h = 0; h < 4; ++h) {
        float L = l[h]; L += __shfl_xor(L, 16); L += __shfl_xor(L, 32);
        const float wgt = gate[h * 3 + 1] / L;
#pragma unroll
        for (int dt = 0; dt < 4; ++dt) fin[(h * 4 + dt) * 64 + lane] = fin[(h * 4 + dt) * 64 + lane] + o[h][dt] * wgt;
    }
#pragma unroll
    for (int h = 0; h < 4; ++h) {
        l[h] = 0.f;
#pragma unroll
        for (int dt = 0; dt < 4; ++dt) o[h][dt] = (f32x4){0.f, 0.f, 0.f, 0.f};
    }
    {
        const int kb0 = (t0 - 512) > 0 ? ((t0 - 512) & ~31) : 0, kbl = t0 & ~31;
        for (int kb = kb0; kb <= kbl; kb += 32) {
            qk_tile(KW + (size_t)kb * 64, qf, s, tl, quad);
            exp_tile<1>(s, sl2, ref_w, tok - kb - 4 * quad, 512u);
#pragma unroll
            for (int h = 0; h < 4; ++h) l[h] += (s[h][0][0] + s[h][0][1]) + (s[h][0][2] + s[h][0][3]) + (s[h][1][0] + s[h][1][1]) + (s[h][1][2] + s[h][1][3]);
            pack_tile(s, pb);
            pv_tile(VWT + (size_t)(kb >> 5) * 64 * 32, pb, o, tl, quad);
        }
    }
    bf16_t* dst = (bf16_t*)(ws + WS_A2) + (size_t)tok * DM + 512 + g * 256 + 4 * quad;
#pragma unroll
    for (int h = 0; h < 4; ++h) {
        float L = l[h]; L += __shfl_xor(L, 16); L += __shfl_xor(L, 32);
        const float wgt = gate[h * 3 + 2] / L;
#pragma unroll
        for (int dt = 0; dt < 4; ++dt) {
            const f32x4 v = fin[(h * 4 + dt) * 64 + lane] + o[h][dt] * wgt;
            u32x2 w; w.x = pk2(v[0], v[1]); w.y = pk2(v[2], v[3]);
            *(u32x2*)(dst + h * 64 + dt * 16) = w;
        }
    }
    LDS_WAIT();
}

DI void attn_phase(const Params& p, LAS unsigned char* lds, int lane, int wave, int G) {
    LAS unsigned char* wl = lds + wave * WAVE_LDS;
    const float gq = wave_max(fabsf(p.in[I_QG][lane]));
    const float ref_c = C2 * 64.f * gq * wave_max(fabsf(p.in[I_KCG][lane]));
    const float ref_s = C2 * 64.f * gq * wave_max(fabsf(p.in[I_KSG][lane]));
    const float ref_w = C2 * 64.f * gq * wave_max(fabsf(p.in[I_KWG][lane]));
    const int sd = wave & 3, hh = wave >> 2;
    for (int pp = blockIdx.x * 4 + sd; pp < 1024; pp += G * 4) {
        const int tp = pp >> 1, g = pp & 1;
        const int tile = hh ? (1023 - tp) : tp;
        attn_unit(p, tile, g, lane, wl, ref_c, ref_s, ref_w);
    }
}

template <bool COOP, int ONLY>
__global__ void __launch_bounds__(512, 2) mega(Params p) {
    extern __shared__ __attribute__((aligned(16))) unsigned char lds_raw[];
    LAS unsigned char* lds = (LAS unsigned char*)lds_raw;
    const int tid = threadIdx.x, lane = tid & 63, wave = __builtin_amdgcn_readfirstlane(tid >> 6), G = gridDim.x;
    unsigned char* ws = p.ws;
    const int lo = p.ph_lo, hi = p.ph_hi;
#define IN(k) ((ONLY < 0 || ONLY == (k)) && lo <= (k) && (k) < hi)
#define SEAM(k) do { if (COOP && IN(k) && IN((k) + 1)) { xcd_barrier(xbar); } } while (0)
    XcdBarrier xbar; xbar.bar = (unsigned*)ws; xbar.x = 0; xbar.st = nullptr;
    if (COOP) {
        volatile LAS unsigned* st = (volatile LAS unsigned*)(lds + LDS_BYTES - 16);
        if (tid < 4) st[tid] = 0u;
        __syncthreads();
        xbar = xcd_barrier_post((unsigned*)ws, st);
    }
    if (IN(0)) phase0(p, lds, tid, lane, wave, G);
    SEAM(0);
    if (IN(1)) phase1(p, lds, tid, lane, wave, G);
    SEAM(1);
    if (IN(2)) {
        pg8::Gemm g{(const bf16_t*)(ws + WS_XB), (const bf16_t*)(ws + WS_WINT), SEQ, NIN, DM};
        pg8::StaticOrder S; S.init(SEQ, NIN, G, (int)blockIdx.x);
        EpiIn E{(const float*)(ws + WS_RSTD1), (const float*)(ws + WS_BIASIN), p.in[I_QG], p.in[I_KSG], p.in[I_KWG],
                (bf16_t*)(ws + WS_U), (bf16_t*)(ws + WS_Q), (bf16_t*)(ws + WS_ACMP), (bf16_t*)(ws + WS_KS), (bf16_t*)(ws + WS_KW), (bf16_t*)(ws + WS_VST), (bf16_t*)(ws + WS_VWT),
                (float*)(ws + WS_G), (LAS float*)(lds + XCH_OFF)};
        pg8::gemm_phase<EpiIn, pg8::StaticOrder, true, true>(lds, g, S, E);
    }
    SEAM(2);
    if (IN(3)) {
        if (blockIdx.x < 32) {
            pg8::Gemm g{(const bf16_t*)(ws + WS_ACMP), (const bf16_t*)(ws + WS_W1CT), 4096, 1024, 1024};
            CmpOrder S{G, (int)blockIdx.x};
            EpiCmp E{(float*)(ws + WS_PCMP)};
            pg8::gemm_phase<EpiCmp, CmpOrder, true, true>(lds, g, S, E);
        } else pooled_phase(p, tid, G);
    }
    SEAM(3);
    if (IN(4)) phase4(p, lds, lane, wave, G);
    SEAM(4);
    if (IN(5)) attn_phase(p, lds, lane, wave, G);
    SEAM(5);
    if (IN(6)) {
        __syncthreads();
        pg8::Gemm g{(const bf16_t*)(ws + WS_A2), (const bf16_t*)(ws + WS_WOUTT), SEQ, DM, DM};
        pg8::StaticOrder S; S.init(SEQ, DM, G, (int)blockIdx.x);
        EpiOut E{p.in[I_X], (const float*)(ws + WS_MOD) + 2 * DM, p.out, (bf16_t*)(ws + WS_XB), (float*)(ws + WS_RSS2)};
        pg8::gemm_phase<EpiOut, pg8::StaticOrder, true, true>(lds, g, S, E);
    }
    SEAM(6);
    if (IN(7)) {
        pg8::Gemm g{(const bf16_t*)(ws + WS_XB), (const bf16_t*)(ws + WS_WFF1T), SEQ, FF, DM};
        pg8::StaticOrder S; S.init(SEQ, FF, G, (int)blockIdx.x);
        EpiFF1 E{(const float*)(ws + WS_RSS2), (const float*)(ws + WS_BIASFF), (bf16_t*)(ws + WS_H)};
        pg8::gemm_phase<EpiFF1, pg8::StaticOrder, true, true>(lds, g, S, E);
    }
    SEAM(7);
    if (IN(8)) {
        pg8::Gemm g{(const bf16_t*)(ws + WS_H), (const bf16_t*)(ws + WS_WFF2T), SEQ, DM, FF};
        pg8::StaticOrder S; S.init(SEQ, DM, G, (int)blockIdx.x);
        EpiFF2 E{(const float*)(ws + WS_MOD) + 5 * DM, p.out};
        pg8::gemm_phase<EpiFF2, pg8::StaticOrder, true, true>(lds, g, S, E);
    }
#undef IN
#undef SEAM
}

#ifndef N_LAUNCH_MODE
#define N_LAUNCH_MODE 1
#endif
#if N_LAUNCH_MODE == 1
#define QUERY_KERNEL mega<true, -1>
#else
#define QUERY_KERNEL mega<false, 2>
template <int K> static void launch_phase(int grid, Params p, hipStream_t stream) {
    p.ph_lo = K; p.ph_hi = K + 1;
    (void)hipFuncSetAttribute((const void*)mega<false, K>, hipFuncAttributeMaxDynamicSharedMemorySize, LDS_BYTES);
    hipLaunchKernelGGL((mega<false, K>), dim3(grid), dim3(512), LDS_BYTES, stream, p);
}
#endif
extern "C" void kernel_launch(void* const* d_in, const int* in_sizes, int n_in, void* d_out, int out_size, void* d_ws, size_t ws_size, hipStream_t stream) {
    static int grid = 0;
    if (grid == 0) {
        if (n_in != 26 || out_size != SEQ * DM || ws_size < WS_END) { fprintf(stderr, "kernel_launch: unexpected problem shape (n_in %d out %d ws %zu)\n", n_in, out_size, ws_size); grid = -1; return; }
        int dev = 0, cus = 0, per_cu = 0;
        (void)hipGetDevice(&dev);
        (void)hipDeviceGetAttribute(&cus, hipDeviceAttributeMultiprocessorCount, dev);
        (void)hipFuncSetAttribute((const void*)QUERY_KERNEL, hipFuncAttributeMaxDynamicSharedMemorySize, LDS_BYTES);
        (void)hipOccupancyMaxActiveBlocksPerMultiprocessor(&per_cu, (const void*)QUERY_KERNEL, 512, LDS_BYTES);
        if (per_cu < 1) { fprintf(stderr, "kernel_launch: occupancy query says %d blocks/CU\n", per_cu); per_cu = 1; }
        grid = cus;
        (void)hipGetLastError();
    }
    if (grid < 0) return;
    Params p{};
    for (int i = 0; i < 26; ++i) p.in[i] = (const float*)d_in[i];
    p.out = (float*)d_out; p.ws = (unsigned char*)d_ws;
#if N_LAUNCH_MODE == 1
    p.ph_lo = 0; p.ph_hi = 9;
    if (hipMemsetAsync(d_ws, 0, 16384, stream) != hipSuccess) { fprintf(stderr, "kernel_launch: memset failed\n"); return; }
    hipLaunchKernelGGL((mega<true, -1>), dim3(grid), dim3(512), LDS_BYTES, stream, p);
#else
    launch_phase<0>(grid, p, stream); launch_phase<1>(grid, p, stream); launch_phase<2>(grid, p, stream);
    launch_phase<3>(grid, p, stream); launch_phase<4>(grid, p, stream); launch_phase<5>(grid, p, stream);
    launch_phase<6>(grid, p, stream); launch_phase<7>(grid, p, stream); launch_phase<8>(grid, p, stream);
#endif
}
```

```cpp
#include <hip/hip_runtime.h>
#include <cstdio>
#include <cstdint>
namespace pg8 {
#define PG8_LAS __attribute__((address_space(3)))
typedef unsigned short bf16_t;
typedef short bf16x8 __attribute__((ext_vector_type(8)));
typedef float f32x4 __attribute__((ext_vector_type(4)));
typedef unsigned u32x4 __attribute__((ext_vector_type(4)));
constexpr int BM = 256, BK = 64, HALF = 128, HTB = HALF * BK * 2  , STAGE_BYTES = 8 * HTB, NXCD = 8, WGM = 8;

__host__ __device__ __forceinline__ int lds_byte(int r, int c) { const int st = (r >> 4) * 2 + (c >> 5), rr = r & 15, cc = c & 31, ob = rr * 64 + cc * 2; return st * 1024 + (ob ^ (((ob >> 9) & 1) << 5)); }
__host__ __device__ __forceinline__ void stage_rc(int b, int& R, int& C) { const int st = b / 1024, sb = b % 1024, swz = sb ^ (((sb >> 9) & 1) << 5); R = (st >> 1) * 16 + swz / 64; C = (st & 1) * 32 + (swz % 64) / 2; }
__host__ __device__ __forceinline__ int perm32(int rho) { const int n = rho >> 4, i = rho & 15; return 8 * (i >> 2) + 4 * n + (i & 3); }

struct Unit { int pm, pn, koff; };
struct Gemm { const bf16_t* A; const bf16_t* Bt; int M, N, K, ld; };

struct StaticOrder {
    int nM, nN, nwg, G, c;
    __host__ __device__ void init(int M, int N, int G_, int c_) { nM = M / BM; nN = N / BM; nwg = nM * nN; G = G_; c = c_; }
    __host__ __device__ bool next(int i, Unit& u) const {
        const long L = (long)i * G + c; if (L >= nwg) return false;
        int wgid = (int)L; { const int q = nwg / NXCD, r = nwg % NXCD, xcd = wgid % NXCD, off = wgid / NXCD; wgid = (xcd < r ? xcd * (q + 1) : r * (q + 1) + (xcd - r) * q) + off; }
        const int nig = WGM * nN, gid = wgid / nig, fm = gid * WGM, gsz = (nM - fm) < WGM ? (nM - fm) : WGM;
        u.pm = fm + ((wgid % nig) % gsz); u.pn = (wgid % nig) / gsz; u.koff = 0; return true;
    }
    __device__ __forceinline__ void a_ready(const Unit&) const {}
    __device__ __forceinline__ void done(const Unit&) const {}
};

__device__ __forceinline__ unsigned cvt_pk_bf16(float lo, float hi) { unsigned r; asm volatile("v_cvt_pk_bf16_f32 %0, %1, %2" : "=v"(r) : "v"(lo), "v"(hi)); return r; }
template <class Epi, class Sched, bool ALIGN_EPI = false, bool SP2 = false>
__device__ __forceinline__ void gemm_phase(PG8_LAS unsigned char* lds, const Gemm g, const Sched& S, const Epi& E) {
    const int tid = threadIdx.x, wid = __builtin_amdgcn_readfirstlane(tid >> 6), lane = tid & 63, wr = wid >> 2, wc = wid & 3, fr = lane & 15, fq = lane >> 4;
    const int K = g.K, nt = K / BK, LD = g.ld;
    unsigned voffA[2], voffB[2];
#pragma unroll
    for (int i = 0; i < 2; ++i) { int R, C; stage_rc(tid * 16 + i * 8192, R, C); const int Rb = Epi::PERM ? ((R & ~31) + perm32(R & 31)) : R;
        voffA[i] = (unsigned)(R * LD + C) * 2u; voffB[i] = (unsigned)(Rb * LD + C) * 2u; }
    const size_t kstep = (size_t)(BK * 2);
    const size_t hstep = (size_t)HALF * LD * 2;
    const size_t tstep = 2 * hstep;
    const unsigned ldsw = (unsigned)wid * 1024u;
    const int aoff = lds_byte(wr * 64 + fr, fq * 8), boff = lds_byte(wc * 32 + fr, fq * 8);
#define PG8_SA(b, h) (((b) * 2 + (h)) * HTB)
#define PG8_SB(b, h) ((4 + (b) * 2 + (h)) * HTB)
#define PG8_STAGE(bufoff, gbase, voff) do { _Pragma("unroll") for (int _i = 0; _i < 2; ++_i) \
        __builtin_amdgcn_global_load_lds((const unsigned*)((const char*)(gbase) + (voff)[_i]), (PG8_LAS unsigned*)(lds + (bufoff) + ldsw + _i * 8192), 16, 0, 0); } while (0)
#define PG8_LDA(dst, b, h) do { _Pragma("unroll") for (int m = 0; m < 4; ++m) _Pragma("unroll") for (int k = 0; k < 2; ++k) dst[m][k] = *(const PG8_LAS bf16x8*)(lds + PG8_SA(b, h) + aoff + m * 2048 + k * 1024); } while (0)
#define PG8_LDB(dst, b, h) do { _Pragma("unroll") for (int n = 0; n < 2; ++n) _Pragma("unroll") for (int k = 0; k < 2; ++k) dst[n][k] = *(const PG8_LAS bf16x8*)(lds + PG8_SB(b, h) + boff + n * 2048 + k * 1024); } while (0)
#define PG8_MMA(ai, bj, At, Bt) do { __builtin_amdgcn_s_setprio(1); _Pragma("unroll") for (int m = 0; m < 4; ++m) _Pragma("unroll") for (int n = 0; n < 2; ++n) _Pragma("unroll") for (int k = 0; k < 2; ++k) \
        acc[ai][bj][m][n] = __builtin_amdgcn_mfma_f32_16x16x32_bf16(Bt[n][k], At[m][k], acc[ai][bj][m][n], 0, 0, 0); __builtin_amdgcn_s_setprio(0); } while (0)
#define PG8_WAIT_V(n) asm volatile("s_waitcnt vmcnt(" #n ")" ::: "memory")
#define PG8_WAIT_L(n) asm volatile("s_waitcnt lgkmcnt(" #n ")" ::: "memory")
#define PG8_BAR __builtin_amdgcn_s_barrier()
#define PG8_SCHED __builtin_amdgcn_sched_barrier(0)
    Unit cur, nxt; int ui = 0;
    if (!S.next(0, cur)) return;
    f32x4 acc[2][2][4][2];
#pragma unroll
    for (int a = 0; a < 2; ++a)
#pragma unroll
        for (int b = 0; b < 2; ++b)
#pragma unroll
            for (int m = 0; m < 4; ++m)
#pragma unroll
                for (int n = 0; n < 2; ++n) acc[a][b][m][n] = (f32x4){0.f, 0.f, 0.f, 0.f};
    bf16x8 At[4][2], B0[2][2], B1[2][2];
    const char* cA = (const char*)g.A + (size_t)cur.pm * tstep + (size_t)cur.koff * 2; const char* cB = (const char*)g.Bt + (size_t)cur.pn * tstep + (size_t)cur.koff * 2;
    S.a_ready(cur);
    if constexpr (SP2) {
        PG8_STAGE(PG8_SB(0, 0), cB, voffB); PG8_STAGE(PG8_SB(0, 1), cB + hstep, voffB); PG8_STAGE(PG8_SA(0, 0), cA, voffA); PG8_STAGE(PG8_SA(0, 1), cA + hstep, voffA);
        if (wr == 1) PG8_BAR;
        PG8_WAIT_V(2); PG8_BAR;
        PG8_STAGE(PG8_SB(1, 0), cB + kstep, voffB); PG8_STAGE(PG8_SA(1, 0), cA + kstep, voffA); PG8_STAGE(PG8_SB(1, 1), cB + hstep + kstep, voffB);
        PG8_WAIT_V(6); PG8_BAR;
    } else {
        PG8_STAGE(PG8_SB(0, 0), cB, voffB); PG8_STAGE(PG8_SA(0, 0), cA, voffA); PG8_STAGE(PG8_SB(0, 1), cB + hstep, voffB); PG8_STAGE(PG8_SA(0, 1), cA + hstep, voffA);
        if (wr == 1) PG8_BAR;
        PG8_WAIT_V(4); PG8_BAR;
        PG8_STAGE(PG8_SB(1, 0), cB + kstep, voffB); PG8_STAGE(PG8_SA(1, 0), cA + kstep, voffA); PG8_STAGE(PG8_SB(1, 1), cB + hstep + kstep, voffB);
        PG8_WAIT_V(6); PG8_BAR;
    }
    for (;;) {
        const bool has_next = S.next(ui + 1, nxt);
        const char* nA = has_next ? (const char*)g.A + (size_t)nxt.pm * tstep + (size_t)nxt.koff * 2 : cA; const char* nB = has_next ? (const char*)g.Bt + (size_t)nxt.pn * tstep + (size_t)nxt.koff * 2 : cB;
        for (int t = 0; t < nt; t += 2) {
            const bool last = (t == nt - 2);
            const char* a1 = cA + (size_t)(t + 1) * kstep;
            const char* a2 = last ? nA : cA + (size_t)(t + 2) * kstep; const char* b2 = last ? nB : cB + (size_t)(t + 2) * kstep;
            const char* a3 = a2 + kstep; const char* b3 = b2 + kstep;
            if (last && has_next) S.a_ready(nxt);
            if constexpr (SP2) {
            PG8_LDB(B0, 0, 0); PG8_LDB(B1, 0, 1); PG8_SCHED; PG8_LDA(At, 0, 0); PG8_STAGE(PG8_SA(1, 1), a1 + hstep, voffA);
            PG8_WAIT_V(8); PG8_WAIT_L(0); PG8_BAR; PG8_MMA(0, 0, At, B0); PG8_MMA(0, 1, At, B1); PG8_BAR; PG8_SCHED;
            PG8_LDA(At, 0, 1); PG8_STAGE(PG8_SB(0, 0), b2, voffB); PG8_STAGE(PG8_SB(0, 1), b2 + hstep, voffB); PG8_STAGE(PG8_SA(0, 0), a2, voffA);
            PG8_WAIT_V(8); PG8_WAIT_L(0); PG8_BAR; PG8_MMA(1, 0, At, B0); PG8_MMA(1, 1, At, B1); PG8_BAR; PG8_SCHED;
            PG8_LDB(B0, 1, 0); PG8_LDB(B1, 1, 1); PG8_SCHED; PG8_LDA(At, 1, 0); PG8_STAGE(PG8_SA(0, 1), a2 + hstep, voffA);
            PG8_WAIT_V(8); PG8_WAIT_L(0); PG8_BAR; PG8_MMA(0, 0, At, B0); PG8_MMA(0, 1, At, B1); PG8_BAR; PG8_SCHED;
            PG8_LDA(At, 1, 1); PG8_STAGE(PG8_SB(1, 0), b3, voffB); PG8_STAGE(PG8_SB(1, 1), b3 + hstep, voffB); PG8_STAGE(PG8_SA(1, 0), a3, voffA);
            PG8_WAIT_V(8); PG8_WAIT_L(0); PG8_BAR; PG8_MMA(1, 0, At, B0); PG8_MMA(1, 1, At, B1); PG8_BAR; PG8_SCHED;
            } else {
            PG8_LDB(B0, 0, 0); PG8_SCHED; PG8_LDA(At, 0, 0); PG8_STAGE(PG8_SA(1, 1), a1 + hstep, voffA);
            PG8_WAIT_L(8); PG8_BAR; PG8_WAIT_L(0); PG8_MMA(0, 0, At, B0); PG8_BAR; PG8_SCHED;
            PG8_LDB(B1, 0, 1); PG8_STAGE(PG8_SB(0, 0), b2, voffB);
            PG8_BAR; PG8_WAIT_L(0); PG8_MMA(0, 1, At, B1); PG8_BAR;
            PG8_LDA(At, 0, 1); PG8_STAGE(PG8_SA(0, 0), a2, voffA);
            PG8_BAR; PG8_WAIT_L(0); PG8_MMA(1, 0, At, B0); PG8_BAR; PG8_SCHED;
            PG8_STAGE(PG8_SB(0, 1), b2 + hstep, voffB);
            PG8_WAIT_V(6); PG8_BAR; PG8_MMA(1, 1, At, B1); PG8_BAR;
            PG8_LDB(B0, 1, 0); PG8_SCHED; PG8_LDA(At, 1, 0); PG8_STAGE(PG8_SA(0, 1), a2 + hstep, voffA);
            PG8_WAIT_L(8); PG8_BAR; PG8_WAIT_L(0); PG8_MMA(0, 0, At, B0); PG8_BAR; PG8_SCHED;
            PG8_LDB(B1, 1, 1); PG8_STAGE(PG8_SB(1, 0), b3, voffB);
            PG8_BAR; PG8_WAIT_L(0); PG8_MMA(0, 1, At, B1); PG8_BAR;
            PG8_LDA(At, 1, 1); PG8_STAGE(PG8_SA(1, 0), a3, voffA);
            PG8_BAR; PG8_WAIT_L(0); PG8_MMA(1, 0, At, B0); PG8_BAR; PG8_SCHED;
            PG8_STAGE(PG8_SB(1, 1), b3 + hstep, voffB);
            PG8_WAIT_V(6); PG8_BAR; PG8_MMA(1, 1, At, B1); PG8_BAR;
            }
        }
        if constexpr (ALIGN_EPI) { if (wr == 0) PG8_BAR; }
        if constexpr (!Epi::AFTER_DRAIN) { E(acc, cur, wr, wc, fr, fq); S.done(cur); }
        if (!has_next) break;
#pragma unroll
        for (int a = 0; a < 2; ++a)
#pragma unroll
            for (int b = 0; b < 2; ++b)
#pragma unroll
                for (int m = 0; m < 4; ++m)
#pragma unroll
                    for (int n = 0; n < 2; ++n) acc[a][b][m][n] = (f32x4){0.f, 0.f, 0.f, 0.f};
        cur = nxt; cA = nA; cB = nB; ++ui;
        if constexpr (ALIGN_EPI) { if (wr == 1) PG8_BAR; }
    }
    PG8_WAIT_V(0);
    if constexpr (!ALIGN_EPI) { if (wr == 0) PG8_BAR; }
    PG8_BAR;
    if constexpr (Epi::AFTER_DRAIN) { E.fused(acc, cur, wr, wc, fr, fq, lds, wid, lane); S.done(cur); }
#undef PG8_SA
#undef PG8_SB
#undef PG8_STAGE
#undef PG8_LDA
#undef PG8_LDB
#undef PG8_MMA
#undef PG8_WAIT_V
#undef PG8_WAIT_L
#undef PG8_BAR
#undef PG8_SCHED
}
}

using pg8::bf16_t; using pg8::bf16x8; using pg8::f32x4; using pg8::u32x4;
#define LAS __attribute__((address_space(3)))
#define DI __device__ __forceinline__
#define LDS_WAIT() asm volatile("s_waitcnt lgkmcnt(0)" ::: "memory")
typedef unsigned u32x2 __attribute__((ext_vector_type(2)));

constexpr int SEQ = 16384, DM = 1024, NIN = 2048, INW = 1816, FF = 4096;
constexpr float EPS = 1e-6f;
constexpr float LOG2E = 1.4426950408889634f;
constexpr float C2 = 0.125f * LOG2E;
constexpr size_t MiB = 1u << 20;
constexpr size_t WS_MOD = 1 * MiB;
constexpr size_t WS_BIASIN = WS_MOD + 32768;
constexpr size_t WS_BIASFF = WS_BIASIN + 8192;
constexpr size_t WS_BIASC = WS_BIASFF + 16384;
constexpr size_t WS_RSTD1 = WS_BIASC + 2048;
constexpr size_t WS_RSS2 = WS_RSTD1 + 65536;
constexpr size_t WS_G = 2 * MiB;
constexpr size_t WS_KCMP = 4 * MiB;
constexpr size_t WS_VCMPT = 4 * MiB + 262144;
constexpr size_t WS_WPB = 4 * MiB + 524288;
constexpr size_t WS_WINT = 5 * MiB;
constexpr size_t WS_WOUTT = 9 * MiB;
constexpr size_t WS_WFF1T = 11 * MiB;
constexpr size_t WS_WFF2T = 19 * MiB;
constexpr size_t WS_W1CT = 27 * MiB;
constexpr size_t WS_PCMP = 29 * MiB;
constexpr size_t WS_XB = 40 * MiB;
constexpr size_t WS_H = 72 * MiB;
constexpr size_t WS_U = 72 * MiB;
constexpr size_t WS_Q = 88 * MiB;
constexpr size_t WS_ACMP = 104 * MiB;
constexpr size_t WS_KS = 112 * MiB;
constexpr size_t WS_KW = 116 * MiB;
constexpr size_t WS_VST = 120 * MiB;
constexpr size_t WS_VWT = 124 * MiB;
constexpr size_t WS_A2 = 128 * MiB;
constexpr size_t WS_PCMP2 = 200 * MiB;
constexpr size_t WS_END = 216 * MiB;
constexpr int LDS_BYTES = 147456;
constexpr int XCH_OFF = 131072;
constexpr int WAVE_LDS = 17408;

struct Params {
    const float* in[26];
    float* out;
    unsigned char* ws;
    int ph_lo, ph_hi;
};
enum { I_X = 0, I_C, I_WADA, I_BADA, I_N1G, I_N2G, I_WIN, I_WPOOL, I_PSCALE, I_QG, I_KCG, I_KSG, I_KWG,
       I_POSK, I_W1K, I_B1K, I_W2K, I_B2K, I_POSV, I_W1V, I_B1V, I_W2V, I_B2V, I_WOUT, I_WFF1, I_WFF2 };

DI unsigned pk2(float lo, float hi) { return pg8::cvt_pk_bf16(lo, hi); }
DI int kperm(int k, int d) { return ((((k >> 4) * 2 + (d >> 5)) * 16 + (k & 15)) * 4 + ((d >> 3) & 3)) * 8 + (d & 7); }
DI int vperm(int k) { return ((k >> 2) & 3) * 8 + (k >> 4) * 4 + (k & 3); }
DI float bf2f(unsigned short h) { return __uint_as_float((unsigned)h << 16); }
DI float wave_sum(float v) {
#pragma unroll
    for (int o = 1; o < 64; o <<= 1) v += __shfl_xor(v, o);
    return v;
}
DI float wave_max(float v) {
#pragma unroll
    for (int o = 1; o < 64; o <<= 1) v = fmaxf(v, __shfl_xor(v, o));
    return v;
}

DI void gemv_item(const float* v, const float* W, int ldw, int K, int j0, int nvalid, const float* bias, float* out, LAS float* red, int tid) {
    const int c4 = tid & 7, kp = tid >> 3, j = j0 + 4 * c4;
    f32x4 s = {0.f, 0.f, 0.f, 0.f};
    if (j < nvalid) {
#pragma unroll 16
        for (int k = kp; k < K; k += 64) s += *(const f32x4*)(W + (size_t)k * ldw + j) * v[k];
    }
    *(LAS f32x4*)(red + kp * 32 + 4 * c4) = s;
    __syncthreads();
    if (tid < 32) {
        float t = 0.f;
#pragma unroll 16
        for (int i = 0; i < 64; ++i) t += red[i * 32 + tid];
        if (j0 + tid < nvalid) out[j0 + tid] = t + (bias ? bias[j0 + tid] : 0.f);
    }
    __syncthreads();
}

DI void transpose_item(const float* W, int ldw, int k0, int n0, int nvalid, const float* sg, const float* sm, bf16_t* WT, int ldt, int row_off, int col_off, LAS float* scr, int lane) {
    {
        const int n = n0 + 4 * (lane & 7); const bool ok = n < nvalid;
        f32x4 v[8];
#pragma unroll
        for (int i = 0; i < 8; ++i) { const int kk = 8 * i + (lane >> 3); v[i] = ok ? *(const f32x4*)(W + (size_t)(k0 + kk) * ldw + n) : (f32x4){0.f, 0.f, 0.f, 0.f}; }
#pragma unroll
        for (int i = 0; i < 8; ++i) {
            const int kk = 8 * i + (lane >> 3);
            if (sg) v[i] = v[i] * (sg[k0 + kk] * (1.f + sm[k0 + kk]));
            LAS float* d = scr + kk * 33 + 4 * (lane & 7);
            d[0] = v[i][0]; d[1] = v[i][1]; d[2] = v[i][2]; d[3] = v[i][3];
        }
    }
    LDS_WAIT();
    const int c = lane & 7;
#pragma unroll
    for (int j = 0; j < 4; ++j) {
        const int n = (lane >> 3) + 8 * j; const LAS float* s = scr + (8 * c) * 33 + n;
        u32x4 o; o.x = pk2(s[0 * 33], s[1 * 33]); o.y = pk2(s[2 * 33], s[3 * 33]); o.z = pk2(s[4 * 33], s[5 * 33]); o.w = pk2(s[6 * 33], s[7 * 33]);
        *(u32x4*)(WT + (size_t)(row_off + n0 + n) * ldt + col_off + k0 + 8 * c) = o;
    }
    LDS_WAIT();
}

DI void phase0(const Params& p, LAS unsigned char* lds, int tid, int lane, int wave, int G) {
    unsigned char* ws = p.ws;
    float* mod = (float*)(ws + WS_MOD);
    LAS float* red = (LAS float*)(lds + XCH_OFF);
    for (int it = blockIdx.x; it < 192 + 16; it += G) {
        if (it < 192) gemv_item(p.in[I_C], p.in[I_WADA], 6 * DM, DM, it * 32, 6 * DM, p.in[I_BADA], mod, red, tid);
        else { const int r = it - 192, kv = r >> 3, j0 = (r & 7) * 32;
            gemv_item(p.in[kv ? I_POSV : I_POSK], p.in[kv ? I_W1V : I_W1K], 256, 2048, j0, 256, p.in[kv ? I_B1V : I_B1K], (float*)(ws + WS_BIASC) + kv * 256, red, tid); }
    }
    LAS float* scr = (LAS float*)(lds + wave * 16384);
    const int gw = blockIdx.x * 8 + wave, NGW = G * 8;
    constexpr int N_ROWS = SEQ / 4, N_TC = 4 * 128, N_WC = 64, N_Z1 = 512, N_Z2 = 64;
    constexpr int NITEMS = N_ROWS + N_TC + N_WC + N_Z1 + N_Z2;
    for (int it = gw; it < NITEMS; it += NGW) {
        int r = it;
        if (r < N_ROWS) {
            f32x4 v[4][4];
#pragma unroll
            for (int q = 0; q < 4; ++q) { const f32x4* xr = (const f32x4*)(p.in[I_X] + (size_t)(4 * r + q) * DM) + lane;
#pragma unroll
                for (int j = 0; j < 4; ++j) v[q][j] = xr[64 * j]; }
#pragma unroll
            for (int q = 0; q < 4; ++q) {
                float s = 0.f;
#pragma unroll
                for (int j = 0; j < 4; ++j) s += (v[q][j].x * v[q][j].x + v[q][j].y * v[q][j].y) + (v[q][j].z * v[q][j].z + v[q][j].w * v[q][j].w);
                s = wave_sum(s);
                if (lane == 0) ((float*)(ws + WS_RSTD1))[4 * r + q] = rsqrtf(s * (1.f / DM) + EPS);
                u32x2* o8 = (u32x2*)((bf16_t*)(ws + WS_XB) + (size_t)(4 * r + q) * DM) + lane;
#pragma unroll
                for (int j = 0; j < 4; ++j) { u32x2 o; o.x = pk2(v[q][j].x, v[q][j].y); o.y = pk2(v[q][j].z, v[q][j].w); o8[64 * j] = o; }
            }
            continue;
        }
        r -= N_ROWS;
        if (r < N_TC) {
            const int piece = r >> 7, q = r & 127, kv = piece >> 1, half = piece & 1;
            transpose_item(p.in[kv ? I_W1V : I_W1K] + (size_t)half * 1024 * 256, 256, (q >> 3) * 64, (q & 7) * 32, 256, nullptr, nullptr, (bf16_t*)(ws + WS_W1CT), 1024, piece * 256, 0, scr, lane);
            continue;
        }
        r -= N_TC;
        if (r < N_WC) {
#pragma unroll 4
            for (int i = 0; i < 16; ++i) {
                const int idx = r * 1024 + i * 64 + lane, g = idx >> 14, d = (idx >> 7) & 127, c = idx & 127;
                ((bf16_t*)(ws + WS_WPB))[g * 16384 + (((c >> 5) * 8 + (d >> 4)) * 16 + (d & 15)) * 32 + ((c >> 3) & 3) * 8 + (c & 7)] = (bf16_t)(pk2(p.in[I_WPOOL][(size_t)(g * 128 + c) * 128 + d] * p.in[I_PSCALE][g * 128 + d], 0.f) & 0xffffu);
            }
            continue;
        }
        r -= N_WC;
        if (r < N_Z1) { u32x4 z = {0u, 0u, 0u, 0u}; *((u32x4*)(ws + WS_KCMP) + (size_t)r * 64 + lane) = z; continue; }
        r -= N_Z1;
        { u32x4 z = {0u, 0u, 0u, 0u}; *((u32x4*)(ws + WS_RSS2) + (size_t)r * 64 + lane) = z; }
    }
}

DI void phase1(const Params& p, LAS unsigned char* lds, int tid, int lane, int wave, int G) {
    unsigned char* ws = p.ws;
    const float* mod = (const float*)(ws + WS_MOD);
    LAS float* red = (LAS float*)(lds + XCH_OFF);
    for (int it = blockIdx.x; it < 57; it += G) gemv_item(mod + 0, p.in[I_WIN], INW, DM, it * 32, INW, nullptr, (float*)(ws + WS_BIASIN), red, tid);
    LAS float* scr = (LAS float*)(lds + wave * 16384);
    const int gw = ((blockIdx.x + 199) % G) * 8 + wave, NGW = G * 8;
    for (int it = gw; it < 16 * 57; it += NGW)
        transpose_item(p.in[I_WIN], INW, (it / 57) * 64, (it % 57) * 32, INW, p.in[I_N1G], mod + 1 * DM, (bf16_t*)(ws + WS_WINT), DM, 0, 0, scr, lane);
}
#define XB_TMO      128
#define XB_XCNT(j)  (256  + 64 * (j))
#define XB_XSUB(j)  (1280 + 64 * (j))
#define XB_XGEN(j)  (2304 + 64 * (j))
#define XB_TOP      3328
#define XB_TOPGEN   3392
#define XCD_BAR_WORDS 3456
#define XB_SPIN_CAP (1u << 18)

__device__ __forceinline__ unsigned xb_ld(unsigned* p)              { return __hip_atomic_load(p, __ATOMIC_RELAXED, __HIP_MEMORY_SCOPE_AGENT); }
__device__ __forceinline__ unsigned xb_add(unsigned* p, unsigned v) { return __hip_atomic_fetch_add(p, v, __ATOMIC_RELAXED, __HIP_MEMORY_SCOPE_AGENT); }
__device__ __forceinline__ unsigned xb_xcc_id() { return (unsigned)__builtin_amdgcn_s_getreg((3 << 11) | 20) & 0xFu; }
#define XB_SPIN(cond, bar) do { unsigned _sp = 0; while (cond) { __builtin_amdgcn_s_sleep(1); \
    if ((++_sp & 255u) == 0u) { if (xb_ld(&(bar)[XB_TMO])) break; if (_sp > XB_SPIN_CAP) { atomicAdd(&(bar)[XB_TMO], 1u); break; } } } } while (0)

struct XcdBarrier {
    unsigned* bar; unsigned x;
    volatile LAS unsigned* st;
};

__device__ __forceinline__ XcdBarrier xcd_barrier_post(unsigned* bar, volatile LAS unsigned* st) {
    XcdBarrier b; b.bar = bar; b.x = xb_xcc_id(); b.st = st;
    if (threadIdx.x == 0) (void)xb_add(&bar[XB_XCNT(b.x)], 1u);
    return b;
}
__device__ __forceinline__ void xcd_barrier_complete(unsigned* bar, unsigned x, unsigned& nloc, unsigned& nx) {
    const unsigned G = gridDim.x * gridDim.y * gridDim.z;
    unsigned sum, cnt, mine, sp = 0u;
    for (;;) {
        sum = 0u; cnt = 0u; mine = 0u;
#pragma unroll
        for (unsigned j = 0; j < 16; ++j) { const unsigned c = xb_ld(&bar[XB_XCNT(j)]); sum += c; cnt += (c > 0u) ? 1u : 0u; mine = (j == x) ? c : mine; }
        if (sum == G) break;
        __builtin_amdgcn_s_sleep(1);
        if ((++sp & 255u) == 0u) { if (xb_ld(&bar[XB_TMO])) break; if (sp > XB_SPIN_CAP) { atomicAdd(&bar[XB_TMO], 1u); break; } }
    }
    nloc = mine > 0u ? mine : 1u; nx = cnt > 0u ? cnt : 1u;
}

__device__ __forceinline__ void xcd_barrier(const XcdBarrier& b) {
    asm volatile("s_waitcnt vmcnt(0)" ::: "memory");
    __syncthreads();
    if (threadIdx.x == 0) {
        unsigned* bar = b.bar;
        __builtin_amdgcn_s_waitcnt(0);
        unsigned nloc = b.st[0], nx = b.st[1];
        if (nloc == 0u) { xcd_barrier_complete(bar, b.x, nloc, nx); b.st[0] = nloc; b.st[1] = nx; }
        const unsigned old = xb_add(&bar[XB_XSUB(b.x)], 1u);
        const unsigned gen = old / nloc;
        if (old + 1u == (gen + 1u) * nloc) {
            __builtin_amdgcn_fence(__ATOMIC_RELEASE, "agent");
            asm volatile("s_waitcnt vmcnt(0)" ::: "memory");
            const unsigned og = xb_add(&bar[XB_TOP], 1u);
            const unsigned tg = og / nx;
            if (og + 1u == (tg + 1u) * nx) xb_add(&bar[XB_TOPGEN], 1u);
            else XB_SPIN(xb_ld(&bar[XB_TOPGEN]) == tg, bar);
            __builtin_amdgcn_fence(__ATOMIC_ACQUIRE, "agent");
            xb_add(&bar[XB_XGEN(b.x)], 1u);
            asm volatile("s_waitcnt vmcnt(0)" ::: "memory");
        } else {
            XB_SPIN(xb_ld(&bar[XB_XGEN(b.x)]) == gen, bar);
            __builtin_amdgcn_fence(__ATOMIC_ACQUIRE, "agent");
            asm volatile("s_waitcnt vmcnt(0)" ::: "memory");
        }
    }
    __syncthreads();
}

DI u32x4 pack8(const f32x4& a, const f32x4& b) { u32x4 w; w.x = pk2(a[0], a[1]); w.y = pk2(a[2], a[3]); w.z = pk2(b[0], b[1]); w.w = pk2(b[2], b[3]); return w; }

struct EpiIn {
    static constexpr bool PERM = true, AFTER_DRAIN = false;
    const float* rstd1; const float* bias; const float* q_gain; const float* ks_gain; const float* kw_gain;
    bf16_t *U, *Q, *ACMP, *KS, *KW, *VST, *VWT; float* G; LAS float* xch;
    DI void operator()(const f32x4 (&acc)[2][2][4][2], const pg8::Unit& u, int wr, int wc, int fr, int fq_in) const {
        const int pn = u.pn, wid = wr * 4 + wc;
        int fq = fq_in; asm volatile("" : "+v"(fq));
        int row0 = u.pm * 256 + wr * 64 + fr, colb = pn * 256 + wc * 32 + 8 * fq;
        asm volatile("" : "+v"(row0), "+v"(colb));
        const int gsel = wc >> 1, d0 = (wc & 1) * 32 + 8 * fq;
#pragma unroll
        for (int bj = 0; bj < 2; ++bj) {
            float ss[2][4];
#pragma unroll
            for (int ai = 0; ai < 2; ++ai)
#pragma unroll
                for (int m = 0; m < 4; ++m) ss[ai][m] = 0.f;
            const bool need_norm = (pn == 2) || (pn == 3) || ((pn == 5 || pn == 6) && bj == 0);
            if (need_norm) {
#pragma unroll
            for (int ai = 0; ai < 2; ++ai)
#pragma unroll
                for (int m = 0; m < 4; ++m) {
                    const float rsv = rstd1[row0 + ai * 128 + m * 16];
                    const f32x4 v0 = acc[ai][bj][m][0] * rsv + *(const f32x4*)(bias + colb + bj * 128), v1 = acc[ai][bj][m][1] * rsv + *(const f32x4*)(bias + colb + bj * 128 + 4);
                    float s = (v0[0] * v0[0] + v0[1] * v0[1]) + (v0[2] * v0[2] + v0[3] * v0[3]) + (v1[0] * v1[0] + v1[1] * v1[1]) + (v1[2] * v1[2] + v1[3] * v1[3]);
                    s += __shfl_xor(s, 16); s += __shfl_xor(s, 32);
                    ss[ai][m] = s;
                }
            if (fq == 0) {
#pragma unroll
                for (int ai = 0; ai < 2; ++ai)
#pragma unroll
                    for (int m = 0; m < 4; ++m) xch[wid * 256 + ((bj * 2 + ai) * 4 + m) * 16 + fr] = ss[ai][m];
            }
            LDS_WAIT(); __builtin_amdgcn_s_barrier(); asm volatile("" ::: "memory");
#pragma unroll
            for (int ai = 0; ai < 2; ++ai)
#pragma unroll
                for (int m = 0; m < 4; ++m) ss[ai][m] += xch[(wid ^ 1) * 256 + ((bj * 2 + ai) * 4 + m) * 16 + fr];
            }
#pragma unroll
            for (int ai = 0; ai < 2; ++ai)
#pragma unroll
                for (int m = 0; m < 4; ++m) {
                    const int row = row0 + ai * 128 + m * 16;
                    const float rsv = rstd1[row];
                    f32x4 v0 = acc[ai][bj][m][0] * rsv + *(const f32x4*)(bias + colb + bj * 128), v1 = acc[ai][bj][m][1] * rsv + *(const f32x4*)(bias + colb + bj * 128 + 4);
                    if (pn < 2) {
                        *(u32x4*)(U + ((((size_t)(row >> 4) * 4 + (pn * 2 + bj)) * 4 + wc) * 16 + (row & 15)) * 32 + 8 * fq) = pack8(v0, v1);
                    } else if (pn < 4) {
                        const float rn = rsqrtf(ss[ai][m] * (1.f / 64.f) + EPS);
                        const f32x4 g0 = *(const f32x4*)(q_gain + d0), g1 = *(const f32x4*)(q_gain + d0 + 4);
                        v0 = v0 * (rn * C2) * g0; v1 = v1 * (rn * C2) * g1;
                        *(u32x4*)(Q + (((((size_t)(row >> 4) * 8 + ((pn - 2) * 4 + bj * 2 + (wc >> 1))) * 2 + (wc & 1)) * 16 + (row & 15)) * 32) + 8 * fq) = pack8(v0, v1);
                    } else if (pn == 4) {
                        *(u32x4*)(ACMP + ((size_t)(bj * 2 + gsel) * SEQ + row) * 64 + d0) = pack8(v0, v1);
                    } else if (pn < 7) {
                        if (bj == 0) {
                            const float* gain = (pn == 5) ? ks_gain : kw_gain;
                            const float rn = rsqrtf(ss[ai][m] * (1.f / 64.f) + EPS);
                            const f32x4 g0 = *(const f32x4*)(gain + d0), g1 = *(const f32x4*)(gain + d0 + 4);
                            v0 = v0 * rn * g0; v1 = v1 * rn * g1;
                            bf16_t* K = (pn == 5) ? KS : KW;
                            *(u32x4*)(K + ((size_t)gsel * SEQ + (row & ~31)) * 64 + kperm(row & 31, d0)) = pack8(v0, v1);
                        } else {
                            bf16_t* VT = ((pn == 5) ? VST : VWT) + (((size_t)gsel * 512 + (row >> 5)) * 64 + d0) * 32 + vperm(row & 31);
                            const u32x4 w = pack8(v0, v1);
                            VT[0 * 32] = (bf16_t)(w.x & 0xffffu); VT[1 * 32] = (bf16_t)(w.x >> 16); VT[2 * 32] = (bf16_t)(w.y & 0xffffu); VT[3 * 32] = (bf16_t)(w.y >> 16);
                            VT[4 * 32] = (bf16_t)(w.z & 0xffffu); VT[5 * 32] = (bf16_t)(w.z >> 16); VT[6 * 32] = (bf16_t)(w.w & 0xffffu); VT[7 * 32] = (bf16_t)(w.w >> 16);
                        }
                    } else {
                        if (bj == 0 && wc == 0 && fq < 3) {
                            f32x4 s0, s1;
#pragma unroll
                            for (int i = 0; i < 4; ++i) { s0[i] = __builtin_amdgcn_rcpf(1.f + __expf(-v0[i])); s1[i] = __builtin_amdgcn_rcpf(1.f + __expf(-v1[i])); }
                            *(f32x4*)(G + (size_t)row * 24 + 8 * fq) = s0; *(f32x4*)(G + (size_t)row * 24 + 8 * fq + 4) = s1;
                        }
                    }
                }
        }
    }
};

struct EpiCmp {
    static constexpr bool PERM = true, AFTER_DRAIN = false;
    float* P;
    DI void operator()(const f32x4 (&acc)[2][2][4][2], const pg8::Unit& u, int wr, int wc, int fr, int fq) const {
        const int row0 = u.pm * 256 + wr * 64 + fr, col0 = (u.pn & 1) * 256 + wc * 32 + 8 * fq;
#pragma unroll
        for (int ai = 0; ai < 2; ++ai)
#pragma unroll
            for (int m = 0; m < 4; ++m)
#pragma unroll
                for (int bj = 0; bj < 2; ++bj) {
                    float* dst = P + (u.koff ? (size_t)4096 * 512 : (size_t)0) + (size_t)(row0 + ai * 128 + m * 16) * 512 + col0 + bj * 128;
                    *(f32x4*)dst = acc[ai][bj][m][0]; *(f32x4*)(dst + 4) = acc[ai][bj][m][1];
                }
    }
};
struct CmpOrder {
    int G, c;
    DI bool next(int i, pg8::Unit& u) const { const long L = (long)i * G + c; if (L >= 64) return false; const int r = (int)L & 31; u.pm = r >> 1; u.pn = (r & 1) + 2 * (u.pm >> 3); u.koff = ((int)L >> 5) * 512; return true; }
    DI void a_ready(const pg8::Unit&) const {}
    DI void done(const pg8::Unit&) const {}
};

struct EpiOut {
    static constexpr bool PERM = true, AFTER_DRAIN = false;
    const float* x; const float* ga1; float* out; bf16_t* X1b; float* rss2;
    DI void operator()(const f32x4 (&acc)[2][2][4][2], const pg8::Unit& u, int wr, int wc, int fr, int fq) const {
        const int row0 = u.pm * 256 + wr * 64 + fr, col0 = u.pn * 256 + wc * 32 + 8 * fq;
        f32x4 gv[2][2];
#pragma unroll
        for (int bj = 0; bj < 2; ++bj)
#pragma unroll
            for (int n = 0; n < 2; ++n) gv[bj][n] = *(const f32x4*)(ga1 + col0 + bj * 128 + 4 * n);
#pragma unroll
        for (int ai = 0; ai < 2; ++ai)
#pragma unroll
            for (int m = 0; m < 4; ++m) {
                const int row = row0 + ai * 128 + m * 16; float s = 0.f;
#pragma unroll
                for (int bj = 0; bj < 2; ++bj) {
                    const size_t off = (size_t)row * DM + col0 + bj * 128;
                    const u32x4 xb = *(const u32x4*)(X1b + off);
                    const f32x4 x0 = {__uint_as_float(xb.x << 16), __uint_as_float(xb.x & 0xffff0000u), __uint_as_float(xb.y << 16), __uint_as_float(xb.y & 0xffff0000u)};
                    const f32x4 x1 = {__uint_as_float(xb.z << 16), __uint_as_float(xb.z & 0xffff0000u), __uint_as_float(xb.w << 16), __uint_as_float(xb.w & 0xffff0000u)};
                    const f32x4 v0 = x0 + gv[bj][0] * acc[ai][bj][m][0], v1 = x1 + gv[bj][1] * acc[ai][bj][m][1];
                    *(u32x4*)(X1b + off) = pack8(v0, v1);
                    s += (v0[0] * v0[0] + v0[1] * v0[1]) + (v0[2] * v0[2] + v0[3] * v0[3]) + (v1[0] * v1[0] + v1[1] * v1[1]) + (v1[2] * v1[2] + v1[3] * v1[3]);
                }
                s += __shfl_xor(s, 16); s += __shfl_xor(s, 32);
                if (fq == 0) atomicAdd(rss2 + row, s);
            }
    }
};

struct EpiFF1 {
    static constexpr bool PERM = true, AFTER_DRAIN = false;
    const float* rss2; const float* bias; bf16_t* H;
    DI void operator()(const f32x4 (&acc)[2][2][4][2], const pg8::Unit& u, int wr, int wc, int fr, int fq) const {
        const int row0 = u.pm * 256 + wr * 64 + fr, col0 = u.pn * 256 + wc * 32 + 8 * fq;
        f32x4 bv[2][2];
#pragma unroll
        for (int bj = 0; bj < 2; ++bj)
#pragma unroll
            for (int n = 0; n < 2; ++n) bv[bj][n] = *(const f32x4*)(bias + col0 + bj * 128 + 4 * n);
#pragma unroll
        for (int ai = 0; ai < 2; ++ai)
#pragma unroll
            for (int m = 0; m < 4; ++m) {
                const int row = row0 + ai * 128 + m * 16;
                const float rs = rsqrtf(rss2[row] * (1.f / DM) + EPS);
#pragma unroll
                for (int bj = 0; bj < 2; ++bj) {
                    f32x4 v0 = acc[ai][bj][m][0] * rs + bv[bj][0], v1 = acc[ai][bj][m][1] * rs + bv[bj][1];
#pragma unroll
                    for (int i = 0; i < 4; ++i) { const float a = fmaxf(v0[i], 0.f), b = fmaxf(v1[i], 0.f); v0[i] = a * a; v1[i] = b * b; }
                    *(u32x4*)(H + (size_t)row * FF + col0 + bj * 128) = pack8(v0, v1);
                }
            }
    }
};

struct EpiFF2 {
    static constexpr bool PERM = true, AFTER_DRAIN = false;
    const float* ga2; float* out; const bf16_t* X1b;
    DI void operator()(const f32x4 (&acc)[2][2][4][2], const pg8::Unit& u, int wr, int wc, int fr, int fq) const {
        const int row0 = u.pm * 256 + wr * 64 + fr, col0 = u.pn * 256 + wc * 32 + 8 * fq;
        f32x4 gv[2][2];
#pragma unroll
        for (int bj = 0; bj < 2; ++bj)
#pragma unroll
            for (int n = 0; n < 2; ++n) gv[bj][n] = *(const f32x4*)(ga2 + col0 + bj * 128 + 4 * n);
#pragma unroll
        for (int ai = 0; ai < 2; ++ai)
#pragma unroll
            for (int m = 0; m < 4; ++m)
#pragma unroll
                for (int bj = 0; bj < 2; ++bj) {
                    const size_t off = (size_t)(row0 + ai * 128 + m * 16) * DM + col0 + bj * 128;
                    float* dst = out + off;
                    const u32x4 xb = *(const u32x4*)(X1b + off);
                    const f32x4 x0 = {__uint_as_float(xb.x << 16), __uint_as_float(xb.x & 0xffff0000u), __uint_as_float(xb.y << 16), __uint_as_float(xb.y & 0xffff0000u)};
                    const f32x4 x1 = {__uint_as_float(xb.z << 16), __uint_as_float(xb.z & 0xffff0000u), __uint_as_float(xb.w << 16), __uint_as_float(xb.w & 0xffff0000u)};
                    *(f32x4*)dst = x0 + gv[bj][0] * acc[ai][bj][m][0]; *(f32x4*)(dst + 4) = x1 + gv[bj][1] * acc[ai][bj][m][1];
                }
    }
};

template <int CTRL> DI float dpp_f(float x) {
    return __uint_as_float((unsigned)__builtin_amdgcn_update_dpp(0, (int)__float_as_uint(x), CTRL, 0xF, 0xF, true));
}
DI float row_scan(float x) {
    x += dpp_f<0x111>(x); x += dpp_f<0x112>(x); x += dpp_f<0x114>(x); x += dpp_f<0x118>(x);
    return x;
}
DI void unpack8(const u32x4& v, float (&f)[8]) {
    f[0] = __uint_as_float(v.x << 16); f[1] = __uint_as_float(v.x & 0xffff0000u); f[2] = __uint_as_float(v.y << 16); f[3] = __uint_as_float(v.y & 0xffff0000u);
    f[4] = __uint_as_float(v.z << 16); f[5] = __uint_as_float(v.z & 0xffff0000u); f[6] = __uint_as_float(v.w << 16); f[7] = __uint_as_float(v.w & 0xffff0000u);
}
template <int W>
DI void pool_item(const Params& p, int tile, int g, int lane) {
    const bf16_t* U = (const bf16_t*)(p.ws + WS_U);
    bf16_t* A2 = (bf16_t*)(p.ws + WS_A2);
    const int tl = lane & 15, quad = lane >> 4, t = tile * 16 + tl;
    const int cnt = (t + 1) < W ? (t + 1) : W;
    const float inv = 1.f / (float)cnt;
    const bf16_t* WpB = (const bf16_t*)(p.ws + WS_WPB) + (size_t)g * 128 * 128;
    f32x4 acc[8];
#pragma unroll
    for (int nt = 0; nt < 8; ++nt) acc[nt] = (f32x4){0.f, 0.f, 0.f, 0.f};
    const int lane15 = ((lane & 48) | 15) << 2;
    const bf16_t* ub = U + ((size_t)tile * 4 + g) * 2048 + tl * 32 + quad * 8;
    u32x4 vcn = *(const u32x4*)ub;
    u32x4 vpn = (tile > 0) ? *(const u32x4*)(ub - 8192) : (u32x4){0u, 0u, 0u, 0u};
#pragma unroll 1
    for (int ks = 0; ks < 4; ++ks) {
        const u32x4 vcc = vcn, vpp = vpn;
        const int kn = (ks < 3) ? ks + 1 : ks;
        vcn = *(const u32x4*)(ub + kn * 512);
        vpn = (tile > 0) ? *(const u32x4*)(ub - 8192 + kn * 512) : (u32x4){0u, 0u, 0u, 0u};
        bf16x8 wf[8];
#pragma unroll
        for (int nt = 0; nt < 8; ++nt) wf[nt] = *(const bf16x8*)(WpB + (size_t)(ks * 8 + nt) * 512 + tl * 32 + quad * 8);
        float c[8], q[8], r[8];
        unpack8(vcc, c); unpack8(vpp, q);
#pragma unroll
        for (int e = 0; e < 8; ++e) {
            const float pc = row_scan(c[e]), pp = row_scan(q[e]);
            const float tot = __uint_as_float((unsigned)__builtin_amdgcn_ds_bpermute(lane15, (int)__float_as_uint(pp)));
            float inside = pc, ppw = pp;
            if constexpr (W < 16) {
                inside = pc - dpp_f<0x110 + W>(pc);
                ppw = dpp_f<0x100 + (16 - W)>(pp);
            }
            const float before = (tl < W) ? (tot - ppw) : 0.f;
            r[e] = (inside + before) * inv - c[e];
        }
        u32x4 o; o.x = pk2(r[0], r[1]); o.y = pk2(r[2], r[3]); o.z = pk2(r[4], r[5]); o.w = pk2(r[6], r[7]);
        const bf16x8 pf = __builtin_bit_cast(bf16x8, o);
#pragma unroll
        for (int nt = 0; nt < 8; ++nt) acc[nt] = __builtin_amdgcn_mfma_f32_16x16x32_bf16(wf[nt], pf, acc[nt], 0, 0, 0);
    }
#pragma unroll
    for (int nt = 0; nt < 8; ++nt) {
        u32x2 o; o.x = pk2(acc[nt][0], acc[nt][1]); o.y = pk2(acc[nt][2], acc[nt][3]);
        *(u32x2*)(A2 + (size_t)t * DM + g * 128 + nt * 16 + 4 * quad) = o;
    }
}
DI void side_items(const Params& p, LAS unsigned char* lds, int lane, int wave, int slot, int nslots, int p_lo, int p_hi, int t_lo, int t_hi) {
    unsigned char* ws = p.ws;
    const float* mod = (const float*)(ws + WS_MOD);
    LAS float* scr = (LAS float*)(lds + wave * 16384);
    for (int r = p_lo + slot; r < p_hi; r += nslots) {
        const int g = 3 - (r >> 10), tile = r & 1023;
        if (g == 0) pool_item<2>(p, tile, 0, lane);
        else if (g == 1) pool_item<4>(p, tile, 1, lane);
        else if (g == 2) pool_item<8>(p, tile, 2, lane);
        else pool_item<16>(p, tile, 3, lane);
    }
    constexpr int N_T1 = 16 * 128, N_T2 = 64 * 32;
    for (int it = t_lo + slot; it < t_hi; it += nslots) {
        int r = it;
        if (r < N_T1) { transpose_item(p.in[I_WFF1], FF, (r >> 7) * 64, (r & 127) * 32, FF, p.in[I_N2G], mod + 4 * DM, (bf16_t*)(ws + WS_WFF1T), DM, 0, 0, scr, lane); continue; }
        r -= N_T1;
        if (r < N_T2) { transpose_item(p.in[I_WFF2], DM, (r >> 5) * 64, (r & 31) * 32, DM, nullptr, nullptr, (bf16_t*)(ws + WS_WFF2T), FF, 0, 0, scr, lane); continue; }
        r -= N_T2;
        transpose_item(p.in[I_WOUT], DM, (r >> 5) * 64, (r & 31) * 32, DM, nullptr, nullptr, (bf16_t*)(ws + WS_WOUTT), DM, 0, 0, scr, lane);
    }
}
constexpr int SIDE_P_SPLIT = 3328, SIDE_T_SPLIT = 3744, SIDE_T_ALL = 16 * 128 + 64 * 32 + 16 * 32;
DI void side_phase(const Params& p, LAS unsigned char* lds, int tid, int lane, int wave, int G) {
    const int nb = G - 64, bid = blockIdx.x - 64;
    LAS float* red = (LAS float*)(lds + XCH_OFF);
    for (int it = bid; it < 128; it += nb) gemv_item((const float*)(p.ws + WS_MOD) + 3 * DM, p.in[I_WFF1], FF, DM, it * 32, FF, nullptr, (float*)(p.ws + WS_BIASFF), red, tid);
    side_items(p, lds, lane, wave, ((bid + 64) % nb) * 8 + wave, nb * 8, 0, SIDE_P_SPLIT, 0, SIDE_T_SPLIT);
}

DI void phase4(const Params& p, LAS unsigned char* lds, int tid, int lane, int wave, int G) {
    unsigned char* ws = p.ws;
    const float* P = (const float*)(ws + WS_PCMP2);
    const float* biasc = (const float*)(ws + WS_BIASC);
    const int kv = blockIdx.x & 1;
    LAS float* w2s = (LAS float*)lds;
    LAS float* hb = (LAS float*)(lds + 65536 + wave * 1024);
    {
        const f32x4* src = (const f32x4*)p.in[kv ? I_W2V : I_W2K];
#pragma unroll
        for (int i = 0; i < 8; ++i) ((LAS f32x4*)w2s)[i * 512 + tid] = src[i * 512 + tid];
    }
    __syncthreads();
    const float b2 = p.in[kv ? I_B2V : I_B2K][lane];
    const int nbw = (G >> 1) * 8;
    for (int r = (blockIdx.x >> 1) * 8 + wave; r < 2 * 1023; r += nbw) {
        const int g = r / 1023, n = r - g * 1023, kvg = kv * 2 + g;
        const float* p0 = P + (size_t)(kvg * 1024 + n) * 512;
#pragma unroll
        for (int i = 0; i < 4; ++i) {
            const int j = lane + 64 * i;
            const float x = (p0[j] + p0[(size_t)4096 * 512 + j]) + (p0[512 + 256 + j] + p0[(size_t)4096 * 512 + 512 + 256 + j]) + biasc[kv * 256 + j];
            const float t = tanhf(0.7978845608028654f * (x + 0.044715f * x * x * x));
            hb[j] = 0.5f * x * (1.f + t);
        }
        LDS_WAIT();
        float o = b2;
#pragma unroll 8
        for (int j4 = 0; j4 < 64; ++j4) {
            const f32x4 h = *(const LAS f32x4*)(hb + 4 * j4);
            o += h[0] * w2s[(4 * j4 + 0) * 64 + lane]; o += h[1] * w2s[(4 * j4 + 1) * 64 + lane];
            o += h[2] * w2s[(4 * j4 + 2) * 64 + lane]; o += h[3] * w2s[(4 * j4 + 3) * 64 + lane];
        }
        if (kv == 0) {
            const float ss = wave_sum(o * o);
            const float y = o * rsqrtf(ss * (1.f / 64.f) + EPS) * p.in[I_KCG][lane];
            ((bf16_t*)(ws + WS_KCMP))[((size_t)g * 1024 + (n & ~31)) * 64 + kperm(n & 31, lane)] = (bf16_t)(pk2(y, 0.f) & 0xffffu);
        } else {
            ((bf16_t*)(ws + WS_VCMPT))[(((size_t)g * 32 + (n >> 5)) * 64 + lane) * 32 + vperm(n & 31)] = (bf16_t)(pk2(o, 0.f) & 0xffffu);
        }
        LDS_WAIT();
    }
}

#define MFMA16(a, b, c) __builtin_amdgcn_mfma_f32_16x16x32_bf16((a), (b), (c), 0, 0, 0)

DI void load_k(const bf16_t* kbase, bf16x8 (&kf)[2][2], int tl, int quad) {
#ifdef PROBE_HOT
    kbase = (const bf16_t*)((uintptr_t)kbase & ~(uintptr_t)0xFFF000);
#endif
#pragma unroll
    for (int ks = 0; ks < 2; ++ks)
#pragma unroll
        for (int dh = 0; dh < 2; ++dh) kf[ks][dh] = *(const bf16x8*)(kbase + (((ks * 2 + dh) * 16 + tl) * 4 + quad) * 8);
}
template <int HFC = 0>
DI void qk_mma(const bf16x8 (&kf)[2][2], const bf16x8 (&qf)[4][2], f32x4 (&s)[4][2]) {
#pragma unroll
    for (int h = HFC; h < 4; ++h)
#pragma unroll
        for (int ks = 0; ks < 2; ++ks) {
            s[h][ks] = MFMA16(kf[ks][0], qf[h][0], s[h][ks]);
            s[h][ks] = MFMA16(kf[ks][1], qf[h][1], s[h][ks]);
        }
}
DI void load_v(const bf16_t* vt, bf16x8 (&vf)[4], int tl, int quad) {
#ifdef PROBE_HOT
    vt = (const bf16_t*)((uintptr_t)vt & ~(uintptr_t)0xFFF000);
#endif
#pragma unroll
    for (int dt = 0; dt < 4; ++dt) {
        vf[dt] = *(const bf16x8*)(vt + (dt * 16 + tl) * 32 + 8 * quad);
    }
}
template <int HFC = 0>
DI void pv_mma(const bf16x8 (&vf)[4], const bf16x8 (&pb)[4], f32x4 (&o)[4][4]) {
#pragma unroll
    for (int dt = 0; dt < 4; ++dt)
#pragma unroll
        for (int h = HFC; h < 4; ++h) o[h][dt] = MFMA16(vf[dt], pb[h], o[h][dt]);
}
template <int HFC = 0>
DI void pv_tile(const bf16_t* vt, const bf16x8 (&pb)[4], f32x4 (&o)[4][4], int tl, int quad) {
#pragma unroll
    for (int hf = 0; hf < 2; ++hf) {
        bf16x8 vf[2];
#pragma unroll
        for (int d2 = 0; d2 < 2; ++d2) {
            const int dt = hf * 2 + d2;
            vf[d2] = *(const bf16x8*)(vt + (dt * 16 + tl) * 32 + 8 * quad);
        }
#pragma unroll
        for (int d2 = 0; d2 < 2; ++d2)
#pragma unroll
            for (int h = HFC; h < 4; ++h) o[h][hf * 2 + d2] = MFMA16(vf[d2], pb[h], o[h][hf * 2 + d2]);
    }
}
DI void l_mma(const bf16x8 (&pb)[4], f32x4 (&la)[4]) {
    u32x4 w1 = {0x3F803F80u, 0x3F803F80u, 0x3F803F80u, 0x3F803F80u};
    const bf16x8 ones = __builtin_bit_cast(bf16x8, w1);
#pragma unroll
    for (int h = 0; h < 4; ++h) la[h] = MFMA16(ones, pb[h], la[h]);
}
template <int STRIDE, int HFC = 0>
DI void bias_init(f32x4 (&s)[4][2], const float (&sl2)[4], const float (&ref)[4], int dbase) {
    const float nd0 = (float)(-dbase);
    float nd[2][4];
#pragma unroll
    for (int ks = 0; ks < 2; ++ks)
#pragma unroll
        for (int i = 0; i < 4; ++i) nd[ks][i] = (float)(STRIDE * (16 * ks + i)) + nd0;
#pragma unroll
    for (int h = HFC; h < 4; ++h)
#pragma unroll
        for (int ks = 0; ks < 2; ++ks)
#pragma unroll
            for (int i = 0; i < 4; ++i) s[h][ks][i] = fmaf(sl2[h], nd[ks][i], -ref[h]);
}
template <int STRIDE, int HFC = 0>
DI void exp_tile(f32x4 (&s)[4][2], int dbase, unsigned lim) {
    const bool allok = ((unsigned)(dbase - 19 * STRIDE) < lim) && ((unsigned)dbase < lim);
    if (__all(allok)) {
#pragma unroll
        for (int h = HFC; h < 4; ++h)
#pragma unroll
            for (int ks = 0; ks < 2; ++ks)
#pragma unroll
                for (int i = 0; i < 4; ++i) s[h][ks][i] = __builtin_amdgcn_exp2f(s[h][ks][i]);
    } else {
        bool ok[2][4];
#pragma unroll
        for (int ks = 0; ks < 2; ++ks)
#pragma unroll
            for (int i = 0; i < 4; ++i) ok[ks][i] = (unsigned)(dbase - STRIDE * (16 * ks + i)) < lim;
#pragma unroll
        for (int h = HFC; h < 4; ++h)
#pragma unroll
            for (int ks = 0; ks < 2; ++ks)
#pragma unroll
                for (int i = 0; i < 4; ++i) { const float e = __builtin_amdgcn_exp2f(s[h][ks][i]); s[h][ks][i] = ok[ks][i] ? e : 0.f; }
    }
}
template <int HFC = 0>
DI void lsum(const f32x4 (&s)[4][2], float (&l)[4]) {
#pragma unroll
    for (int h = HFC; h < 4; ++h) { const f32x4 t = s[h][0] + s[h][1]; l[h] += (t[0] + t[1]) + (t[2] + t[3]); }
}
template <int HFC = 0>
DI void pack_tile(const f32x4 (&s)[4][2], bf16x8 (&pb)[4]) {
#pragma unroll
    for (int h = HFC; h < 4; ++h) pb[h] = __builtin_bit_cast(bf16x8, pack8(s[h][0], s[h][1]));
}
DI void list_insert(unsigned (&lst)[16], unsigned key) {
#pragma unroll
    for (int i = 0; i < 16; ++i) { const unsigned hi = lst[i] > key ? lst[i] : key, lo = lst[i] > key ? key : lst[i]; lst[i] = hi; key = lo; }
}

DI void attn_unit(const Params& p, int tile, int g, int lane, LAS unsigned char* wl, float ref_c, float ref_s, float ref_w, int mode, LAS unsigned char* pl) {
    unsigned char* ws = p.ws;
    const int t0 = tile * 16, tl = lane & 15, quad = lane >> 4, tok = t0 + tl, cur = t0 >> 6;
    LAS f32x4* fin = (LAS f32x4*)wl;
    LAS unsigned* lstx = (LAS unsigned*)wl;
    LAS unsigned* keysL = (LAS unsigned*)wl;
    LAS unsigned* msk = (LAS unsigned*)(wl + 16512);
    LAS unsigned* uni = msk + 128;
    LAS unsigned char* ulist = (LAS unsigned char*)(uni + 8);
    const bf16_t* Q = (const bf16_t*)(ws + WS_Q);
    const bf16_t* KC = (const bf16_t*)(ws + WS_KCMP) + (size_t)g * 1024 * 64;
    const bf16_t* VCT = (const bf16_t*)(ws + WS_VCMPT) + (size_t)g * 32 * 64 * 32;
    const bf16_t* KS = (const bf16_t*)(ws + WS_KS) + (size_t)g * SEQ * 64;
    const bf16_t* VST = (const bf16_t*)(ws + WS_VST) + (size_t)g * 512 * 64 * 32;
    const bf16_t* KW = (const bf16_t*)(ws + WS_KW) + (size_t)g * SEQ * 64;
    const bf16_t* VWT = (const bf16_t*)(ws + WS_VWT) + (size_t)g * 512 * 64 * 32;
    const float* gate = (const float*)(ws + WS_G) + (size_t)tok * 24 + g * 12;

    bf16x8 qf[4][2];
#pragma unroll
    for (int h = 0; h < 4; ++h)
#pragma unroll
        for (int dh = 0; dh < 2; ++dh) qf[h][dh] = *(const bf16x8*)(Q + ((((size_t)tile * 8 + (g * 4 + h)) * 2 + dh) * 16 + tl) * 32 + quad * 8);
    float sl2[4], ref[4];
#pragma unroll
    for (int h = 0; h < 4; ++h) { sl2[h] = __uint_as_float(__float_as_uint(LOG2E) - ((unsigned)(g * 4 + h + 1) << 23)); ref[h] = ref_c; }

    f32x4 s[4][2]; f32x4 o[4][4]; float l[4]; bf16x8 pb[4]; bf16x8 kf[2][2];
    const int NT = (cur >> 3) + 1;
    const int dc0 = tok - 31 - 64 * quad;
#pragma unroll
    for (int h = 0; h < 4; ++h) l[h] = 0.f;
    const int T0 = (g == 0 && t0 >= 2207) ? ((t0 - 2207) >> 9) + 1 : 0;
    load_k(KC + (size_t)T0 * 32 * 64, kf, tl, quad);
    const int dz2 = 212 << (g * 4 + 1);
#define P1_TILE(HFC) { \
        bias_init<16, HFC>(s, sl2, ref, dc0 - 512 * T); \
        qk_mma<HFC>(kf, qf, s); \
        load_k(KC + (size_t)((T + 1 < NT) ? T + 1 : T) * 32 * 64, kf, tl, quad); \
        exp_tile<16, HFC>(s, dc0 - 512 * T, 0x80000000u); \
        lsum<HFC>(s, l); }
    {
        int T = T0;
        for (; T < NT && (t0 - 512 * T - 527) >= dz2; ++T) P1_TILE(2)
        for (; T < NT; ++T) P1_TILE(0)
    }
#undef P1_TILE
#pragma unroll
    for (int h = 0; h < 4; ++h) { float L = l[h]; L += __shfl_xor(L, 16); L += __shfl_xor(L, 32); ref[h] = ref_c + __builtin_amdgcn_logf(L); }
#pragma unroll
    for (int h = 0; h < 4; ++h)
#pragma unroll
        for (int dt = 0; dt < 4; ++dt) o[h][dt] = (f32x4){0.f, 0.f, 0.f, 0.f};
    float carry = 0.f;
    for (int T = 0; T < T0; ++T) {
        const int j0 = 8 * T + quad, j1 = j0 + 4;
        keysL[tl * 257 + j0] = ((j0 == 0) ? 0x7F000000u : 0u) | 0x100u | (unsigned)(255 - j0);
        keysL[tl * 257 + j1] = 0x100u | (unsigned)(255 - j1);
    }
    load_k(KC + (size_t)T0 * 32 * 64, kf, tl, quad);
#define P2_TILE(HFC) { \
        bias_init<16, HFC>(s, sl2, ref, dc0 - 512 * T); \
        qk_mma<HFC>(kf, qf, s); \
        load_k(KC + (size_t)((T + 1 < NT) ? T + 1 : T) * 32 * 64, kf, tl, quad); \
        exp_tile<16, HFC>(s, dc0 - 512 * T, 0x80000000u); \
        float a0 = 0.f, a1 = 0.f, b0 = 0.f, b1 = 0.f; \
_Pragma("unroll") for (int h = HFC; h < 4; ++h) { \
            a0 += (s[h][0][0] + s[h][0][1]) + (s[h][0][2] + 0.5f * s[h][0][3]); b0 += 0.5f * s[h][0][3]; \
            a1 += (s[h][1][0] + s[h][1][1]) + (s[h][1][2] + 0.5f * s[h][1][3]); b1 += 0.5f * s[h][1][3]; \
        } \
        pack_tile<HFC>(s, pb); \
        pv_tile<HFC>(VCT + (size_t)T * 64 * 32, pb, o, tl, quad); \
        const float bs0 = __shfl(b0, (lane + 48) & 63), bs1 = __shfl(b1, (lane + 48) & 63); \
        const float imp0 = a0 + (quad ? bs0 : carry), imp1 = a1 + (quad ? bs1 : bs0); \
        carry = bs1; \
        const int j0 = 8 * T + quad, j1 = j0 + 4; \
        { \
            const bool forced = (j0 == 0) || (j0 == cur) || (j0 == cur - 1); \
            unsigned key = forced ? 0x7F000000u : (__float_as_uint(imp0) & 0xFFFFFE00u); \
            key = (j0 <= cur) ? (key | 0x100u | (unsigned)(255 - j0)) : 0u; \
            keysL[tl * 257 + j0] = key; \
        } \
        { \
            const bool forced = (j1 == 0) || (j1 == cur) || (j1 == cur - 1); \
            unsigned key = forced ? 0x7F000000u : (__float_as_uint(imp1) & 0xFFFFFE00u); \
            key = (j1 <= cur) ? (key | 0x100u | (unsigned)(255 - j1)) : 0u; \
            keysL[tl * 257 + j1] = key; \
        } }
    {
        int T = T0;
        for (; T < NT && (t0 - 512 * T - 527) >= dz2; ++T) P2_TILE(2)
        for (; T < NT; ++T) P2_TILE(0)
    }
#undef P2_TILE
    LDS_WAIT();
    unsigned lst[16];
#pragma unroll
    for (int i = 0; i < 16; ++i) lst[i] = 0u;
    {
        const int jtop = cur - ((cur - quad) & 3);
        for (int m = 0; m <= (cur >> 2); ++m) {
            const int j = jtop - 4 * m;
            const unsigned key = (j >= 0) ? keysL[tl * 257 + (j >= 0 ? j : 0)] : 0u;
            if (__any(key > lst[15])) list_insert(lst, key);
        }
    }
    LDS_WAIT();
#pragma unroll
    for (int i = 0; i < 16; ++i) lstx[(tl * 4 + quad) * 16 + i] = lst[i];
    LDS_WAIT();
    if (quad == 0) {
        for (int qq = 1; qq < 4; ++qq) {
#pragma unroll
            for (int i = 0; i < 16; ++i) list_insert(lst, lstx[(tl * 4 + qq) * 16 + i]);
        }
        unsigned mw[8];
#pragma unroll
        for (int w = 0; w < 8; ++w) mw[w] = 0u;
#pragma unroll
        for (int i = 0; i < 16; ++i) {
            const unsigned key = lst[i]; const int j = 255 - (int)(key & 0xFFu); const unsigned bit = key ? (1u << (j & 31)) : 0u;
#pragma unroll
            for (int w = 0; w < 8; ++w) mw[w] |= ((j >> 5) == w) ? bit : 0u;
        }
#pragma unroll
        for (int w = 0; w < 8; ++w) msk[tl * 8 + w] = mw[w];
    }
    LDS_WAIT();
    if (lane < 8) {
        unsigned u = 0u;
#pragma unroll
        for (int tk = 0; tk < 16; ++tk) u |= msk[tk * 8 + lane];
        uni[lane] = u;
    }
    LDS_WAIT();
    int nu = 0;
    {
        int off = 0;
#pragma unroll
        for (int w = 0; w < 8; ++w) { const int pc = __builtin_popcount(uni[w]); off += (w < lane) ? pc : 0; nu += pc; }
        if (lane < 8) { unsigned u = uni[lane]; while (u) { const int b = __builtin_ctz(u); u &= u - 1u; ulist[off++] = (unsigned char)(lane * 32 + b); } }
    }
    LDS_WAIT();
#ifdef PROBE_NU
    if (tile == PROBE_NU && g == 1 && lane == 0) ((volatile unsigned*)p.ws)[3900] = (unsigned)nu;
#endif
#pragma unroll
    for (int h = 0; h < 4; ++h) {
        const float gc = gate[h * 3 + 0];
#pragma unroll
        for (int dt = 0; dt < 4; ++dt) fin[(h * 4 + dt) * 64 + lane] = o[h][dt] * gc;
    }
#pragma unroll
    for (int h = 0; h < 4; ++h) {
        ref[h] = ref_s; l[h] = 0.f;
#pragma unroll
        for (int dt = 0; dt < 4; ++dt) o[h][dt] = (f32x4){0.f, 0.f, 0.f, 0.f};
    }
    {
        const int nsel = 2 * __builtin_amdgcn_readfirstlane(nu);
        int j = __builtin_amdgcn_readfirstlane((int)ulist[0]);
        load_k(KS + (size_t)j * 64 * 64, kf, tl, quad);
#define SEL_TILE(HFC) { \
            const int kb = j * 64 + (idx & 1) * 32; \
            const unsigned mym = msk[tl * 8 + (j >> 5)]; \
            const float rsel = ((mym >> (j & 31)) & 1u) ? ref_s : 1e30f; \
            _Pragma("unroll") for (int h = 0; h < 4; ++h) ref[h] = rsel; \
            bf16x8 vf[4]; \
            load_v(VST + (size_t)(kb >> 5) * 64 * 32, vf, tl, quad); \
            bias_init<1, HFC>(s, sl2, ref, tok - kb - 4 * quad); \
            qk_mma<HFC>(kf, qf, s); \
            const int idn = (idx + 1 < nsel) ? idx + 1 : idx; \
            const int jn = __builtin_amdgcn_readfirstlane((int)ulist[idn >> 1]); \
            load_k(KS + (size_t)(jn * 64 + (idn & 1) * 32) * 64, kf, tl, quad); \
            exp_tile<1, HFC>(s, tok - kb - 4 * quad, 0x80000000u); \
            lsum<HFC>(s, l); \
            pack_tile<HFC>(s, pb); \
            pv_mma<HFC>(vf, pb, o); \
            j = jn; }
        int idx = 0;
        for (; idx < nsel && (t0 - (j * 64 + (idx & 1) * 32) - 31) >= dz2; ++idx) SEL_TILE(2)
        for (; idx < nsel; ++idx) SEL_TILE(0)
#undef SEL_TILE
    }
#pragma unroll
    for (int h = 0; h < 4; ++h) {
        float L = l[h]; L += __shfl_xor(L, 16); L += __shfl_xor(L, 32);
        const float wgt = gate[h * 3 + 1] / L;
#pragma unroll
        for (int dt = 0; dt < 4; ++dt) fin[(h * 4 + dt) * 64 + lane] = fin[(h * 4 + dt) * 64 + lane] + o[h][dt] * wgt;
    }
    LAS unsigned* flag = (LAS unsigned*)(wl + 17344);
    bf16_t* dst = (bf16_t*)(ws + WS_A2) + (size_t)tok * DM + 512 + g * 256 + 4 * quad;
    const int nrep = (mode == 1) ? 0 : ((mode == 2) ? 2 : 1);
#pragma unroll 1
    for (int rep = 0; rep < nrep; ++rep) {
        const int gw = rep ? 1 : g;
        if (rep) {
#pragma unroll
            for (int h = 0; h < 4; ++h) {
                sl2[h] = __uint_as_float(__float_as_uint(LOG2E) - ((unsigned)(gw * 4 + h + 1) << 23));
#pragma unroll
                for (int dh = 0; dh < 2; ++dh) qf[h][dh] = *(const bf16x8*)(Q + ((((size_t)tile * 8 + (gw * 4 + h)) * 2 + dh) * 16 + tl) * 32 + quad * 8);
            }
        }
        const bf16_t* KWg = (const bf16_t*)(ws + WS_KW) + (size_t)gw * SEQ * 64;
        const bf16_t* VWTg = (const bf16_t*)(ws + WS_VWT) + (size_t)gw * 512 * 64 * 32;
        const float* gatew = (const float*)(ws + WS_G) + (size_t)tok * 24 + gw * 12;
#pragma unroll
        for (int h = 0; h < 4; ++h) {
            ref[h] = ref_w; l[h] = 0.f;
#pragma unroll
            for (int dt = 0; dt < 4; ++dt) o[h][dt] = (f32x4){0.f, 0.f, 0.f, 0.f};
        }
        {
            const int kb0 = (t0 - 512) > 0 ? ((t0 - 512) & ~31) : 0, kbl = t0 & ~31;
            load_k(KWg + (size_t)kb0 * 64, kf, tl, quad);
#define W_TILE(HFC) { \
                bf16x8 vf[4]; \
                load_v(VWTg + (size_t)(kb >> 5) * 64 * 32, vf, tl, quad); \
                bias_init<1, HFC>(s, sl2, ref, tok - kb - 4 * quad); \
                qk_mma<HFC>(kf, qf, s); \
                load_k(KWg + (size_t)((kb + 32 <= kbl) ? kb + 32 : kb) * 64, kf, tl, quad); \
                exp_tile<1, HFC>(s, tok - kb - 4 * quad, 512u); \
                lsum<HFC>(s, l); \
                pack_tile<HFC>(s, pb); \
                pv_mma<HFC>(vf, pb, o); }
            const int dzw = 212 << (gw * 4 + 1);
            int kb = kb0;
            for (; kb <= kbl && (t0 - kb - 31) >= dzw; kb += 32) W_TILE(2)
            for (; kb <= kbl; kb += 32) W_TILE(0)
#undef W_TILE
        }
        if (rep) LDS_WAIT();
#pragma unroll
        for (int h = 0; h < 4; ++h) {
            float L = l[h]; L += __shfl_xor(L, 16); L += __shfl_xor(L, 32);
            const float wgt = gatew[h * 3 + 2] / L;
#pragma unroll
            for (int dt = 0; dt < 4; ++dt) {
                if (rep == 0) {
                    const f32x4 v = fin[(h * 4 + dt) * 64 + lane] + o[h][dt] * wgt;
                    u32x2 w; w.x = pk2(v[0], v[1]); w.y = pk2(v[2], v[3]);
                    *(u32x2*)(dst + h * 64 + dt * 16) = w;
                } else {
                    fin[(h * 4 + dt) * 64 + lane] = o[h][dt] * wgt;
                }
            }
        }
    }
    if (mode == 2) {
        LDS_WAIT();
        if (lane == 0) *(volatile LAS unsigned*)flag = 1u;
        LDS_WAIT();
    }
    if (mode == 1) {
        volatile LAS unsigned* pflag = (volatile LAS unsigned*)(pl + 17344);
        unsigned sp = 0;
        while (*pflag == 0u) { __builtin_amdgcn_s_sleep(8); if (++sp > (1u << 20)) break; }
        asm volatile("" ::: "memory");
        LAS f32x4* pfin = (LAS f32x4*)pl;
#pragma unroll
        for (int h = 0; h < 4; ++h)
#pragma unroll
            for (int dt = 0; dt < 4; ++dt) {
                const f32x4 v = fin[(h * 4 + dt) * 64 + lane] + pfin[(h * 4 + dt) * 64 + lane];
                u32x2 w; w.x = pk2(v[0], v[1]); w.y = pk2(v[2], v[3]);
                *(u32x2*)(dst + h * 64 + dt * 16) = w;
            }
    }
    LDS_WAIT();
}

DI void attn_phase(const Params& p, LAS unsigned char* lds, int lane, int wave, int G) {
    LAS unsigned char* wl = lds + wave * WAVE_LDS;
    const float gq = wave_max(fabsf(p.in[I_QG][lane]));
    const float ref_c = __uint_as_float(__builtin_amdgcn_readfirstlane(__float_as_uint(C2 * 64.f * gq * wave_max(fabsf(p.in[I_KCG][lane])))));
    const float ref_s = __uint_as_float(__builtin_amdgcn_readfirstlane(__float_as_uint(C2 * 64.f * gq * wave_max(fabsf(p.in[I_KSG][lane])))));
    const float ref_w = __uint_as_float(__builtin_amdgcn_readfirstlane(__float_as_uint(C2 * 64.f * gq * wave_max(fabsf(p.in[I_KWG][lane])))));
    const int sd = wave & 3, hh = wave >> 2;
    if (lane == 0) *(volatile LAS unsigned*)(wl + 17344) = 0u;
    __syncthreads();
    if (G == 256) {
        const int x = blockIdx.x & 7, cu = blockIdx.x >> 3, g = (sd < 2) ? 1 : 0, i = cu * 2 + (sd & 1);
        const int tile = hh ? (1023 - 64 * x - i) : (64 * x + i);
        const int mode = g ? 1 : 2;
        attn_unit(p, tile, g, lane, wl, ref_c, ref_s, ref_w, mode, lds + ((wave + 2) & 7) * WAVE_LDS);
    } else {
        for (int pp = blockIdx.x * 4 + sd; pp < 1024; pp += G * 4) {
            const int tp = pp >> 1, g = pp & 1;
            const int tile = hh ? (1023 - tp) : tp;
            attn_unit(p, tile, g, lane, wl, ref_c, ref_s, ref_w, 0, wl);
        }
    }
}

template <bool COOP, int ONLY>
__global__ void __launch_bounds__(512, 2) mega(Params p) {
    extern __shared__ __attribute__((aligned(16))) unsigned char lds_raw[];
    LAS unsigned char* lds = (LAS unsigned char*)lds_raw;
    const int tid = threadIdx.x, lane = tid & 63, wave = __builtin_amdgcn_readfirstlane(tid >> 6), G = gridDim.x;
    unsigned char* ws = p.ws;
    const int lo = p.ph_lo, hi = p.ph_hi;
#define IN(k) ((ONLY < 0 || ONLY == (k)) && lo <= (k) && (k) < hi)
#define SEAM(k) do { if (COOP && IN(k) && IN((k) + 1)) { xcd_barrier(xbar); } } while (0)
    XcdBarrier xbar; xbar.bar = (unsigned*)ws; xbar.x = 0; xbar.st = nullptr;
    if (COOP) {
        volatile LAS unsigned* st = (volatile LAS unsigned*)(lds + LDS_BYTES - 16);
        if (tid < 4) st[tid] = 0u;
        __syncthreads();
        xbar = xcd_barrier_post((unsigned*)ws, st);
    }
#ifdef PROBE_PHASE
#ifndef PROBE_END
#define PROBE_END (PROBE_PHASE + 1)
#endif
    unsigned long long tA = 0, tB = 0;
#define TSTAMP(k) do { if (PROBE_PHASE == (k)) tA = __builtin_amdgcn_s_memrealtime(); if (PROBE_END == (k)) tB = __builtin_amdgcn_s_memrealtime(); } while (0)
#else
#define TSTAMP(k) do {} while (0)
#endif
    TSTAMP(0);
    if (IN(0)) phase0(p, lds, tid, lane, wave, G);
    SEAM(0);
    TSTAMP(1);
    if (IN(1)) phase1(p, lds, tid, lane, wave, G);
    SEAM(1);
    TSTAMP(2);
    if (IN(2)) {
        pg8::Gemm g{(const bf16_t*)(ws + WS_XB), (const bf16_t*)(ws + WS_WINT), SEQ, NIN, DM, DM};
        pg8::StaticOrder S; S.init(SEQ, NIN, G, (int)blockIdx.x);
        EpiIn E{(const float*)(ws + WS_RSTD1), (const float*)(ws + WS_BIASIN), p.in[I_QG], p.in[I_KSG], p.in[I_KWG],
                (bf16_t*)(ws + WS_U), (bf16_t*)(ws + WS_Q), (bf16_t*)(ws + WS_ACMP), (bf16_t*)(ws + WS_KS), (bf16_t*)(ws + WS_KW), (bf16_t*)(ws + WS_VST), (bf16_t*)(ws + WS_VWT),
                (float*)(ws + WS_G), (LAS float*)(lds + XCH_OFF)};
        pg8::gemm_phase<EpiIn, pg8::StaticOrder, true, true>(lds, g, S, E);
    }
    SEAM(2);
    TSTAMP(3);
    if (IN(3)) {
        if (blockIdx.x < 64) {
            pg8::Gemm g{(const bf16_t*)(ws + WS_ACMP), (const bf16_t*)(ws + WS_W1CT), 4096, 1024, 512, 1024};
            CmpOrder S{G, (int)blockIdx.x};
            EpiCmp E{(float*)(ws + WS_PCMP2)};
            pg8::gemm_phase<EpiCmp, CmpOrder, true, true>(lds, g, S, E);
            side_items(p, lds, lane, wave, (int)blockIdx.x * 8 + wave, 64 * 8, SIDE_P_SPLIT, 4096, SIDE_T_SPLIT, SIDE_T_ALL);
        } else side_phase(p, lds, tid, lane, wave, G);
    }
    SEAM(3);
    TSTAMP(4);
    if (IN(4)) phase4(p, lds, tid, lane, wave, G);
    SEAM(4);
    TSTAMP(5);
    if (IN(5)) attn_phase(p, lds, lane, wave, G);
    SEAM(5);
    TSTAMP(6);
    if (IN(6)) {
        __syncthreads();
        pg8::Gemm g{(const bf16_t*)(ws + WS_A2), (const bf16_t*)(ws + WS_WOUTT), SEQ, DM, DM, DM};
        pg8::StaticOrder S; S.init(SEQ, DM, G, (int)blockIdx.x);
        EpiOut E{p.in[I_X], (const float*)(ws + WS_MOD) + 2 * DM, p.out, (bf16_t*)(ws + WS_XB), (float*)(ws + WS_RSS2)};
        pg8::gemm_phase<EpiOut, pg8::StaticOrder, true, true>(lds, g, S, E);
    }
    SEAM(6);
    TSTAMP(7);
    if (IN(7)) {
        pg8::Gemm g{(const bf16_t*)(ws + WS_XB), (const bf16_t*)(ws + WS_WFF1T), SEQ, FF, DM, DM};
        pg8::StaticOrder S; S.init(SEQ, FF, G, (int)blockIdx.x);
        EpiFF1 E{(const float*)(ws + WS_RSS2), (const float*)(ws + WS_BIASFF), (bf16_t*)(ws + WS_H)};
        pg8::gemm_phase<EpiFF1, pg8::StaticOrder, true, true>(lds, g, S, E);
    }
    SEAM(7);
    TSTAMP(8);
    if (IN(8)) {
        pg8::Gemm g{(const bf16_t*)(ws + WS_H), (const bf16_t*)(ws + WS_WFF2T), SEQ, DM, FF, FF};
        pg8::StaticOrder S; S.init(SEQ, DM, G, (int)blockIdx.x);
        EpiFF2 E{(const float*)(ws + WS_MOD) + 5 * DM, p.out, (const bf16_t*)(ws + WS_XB)};
        pg8::gemm_phase<EpiFF2, pg8::StaticOrder, true, true>(lds, g, S, E);
    }
#ifdef PROBE_NU
    if (COOP) { xcd_barrier(xbar); if (blockIdx.x == 0 && tid == 0) p.out[0] += (float)((volatile unsigned*)p.ws)[3900] * 0.01f; }
#endif
#ifdef PROBE_PHASE
    if (COOP) { xcd_barrier(xbar); TSTAMP(9); if (blockIdx.x == 0 && tid == 0) p.out[0] += (float)(tB - tA) * PROBE_SCALE; }
#endif
#undef IN
#undef SEAM
}

#ifndef N_LAUNCH_MODE
#define N_LAUNCH_MODE 1
#endif
#if N_LAUNCH_MODE == 1
#define QUERY_KERNEL mega<true, -1>
#else
#define QUERY_KERNEL mega<false, 2>
template <int K> static void launch_phase(int grid, Params p, hipStream_t stream) {
    p.ph_lo = K; p.ph_hi = K + 1;
    (void)hipFuncSetAttribute((const void*)mega<false, K>, hipFuncAttributeMaxDynamicSharedMemorySize, LDS_BYTES);
    hipLaunchKernelGGL((mega<false, K>), dim3(grid), dim3(512), LDS_BYTES, stream, p);
}
#endif
extern "C" void kernel_launch(void* const* d_in, const int* in_sizes, int n_in, void* d_out, int out_size, void* d_ws, size_t ws_size, hipStream_t stream) {
    static int grid = 0;
    if (grid == 0) {
        if (n_in != 26 || out_size != SEQ * DM || ws_size < WS_END) { fprintf(stderr, "kernel_launch: unexpected problem shape (n_in %d out %d ws %zu)\n", n_in, out_size, ws_size); grid = -1; return; }
        int dev = 0, cus = 0, per_cu = 0;
        (void)hipGetDevice(&dev);
        (void)hipDeviceGetAttribute(&cus, hipDeviceAttributeMultiprocessorCount, dev);
        (void)hipFuncSetAttribute((const void*)QUERY_KERNEL, hipFuncAttributeMaxDynamicSharedMemorySize, LDS_BYTES);
        (void)hipOccupancyMaxActiveBlocksPerMultiprocessor(&per_cu, (const void*)QUERY_KERNEL, 512, LDS_BYTES);
        if (per_cu < 1) { fprintf(stderr, "kernel_launch: occupancy query says %d blocks/CU\n", per_cu); per_cu = 1; }
        grid = cus;
        (void)hipGetLastError();
    }
    if (grid < 0) return;
    Params p{};
    for (int i = 0; i < 26; ++i) p.in[i] = (const float*)d_in[i];
    p.out = (float*)d_out; p.ws = (unsigned char*)d_ws;
#if N_LAUNCH_MODE == 1
    p.ph_lo = 0; p.ph_hi = 9;
    if (hipMemsetAsync(d_ws, 0, 16384, stream) != hipSuccess) { fprintf(stderr, "kernel_launch: memset failed\n"); return; }
    hipLaunchKernelGGL((mega<true, -1>), dim3(grid), dim3(512), LDS_BYTES, stream, p);
#else
    launch_phase<0>(grid, p, stream); launch_phase<1>(grid, p, stream); launch_phase<2>(grid, p, stream);
    launch_phase<3>(grid, p, stream); launch_phase<4>(grid, p, stream); launch_phase<5>(grid, p, stream);
    launch_phase<6>(grid, p, stream); launch_phase<7>(grid, p, stream); launch_phase<8>(grid, p, stream);
#endif
}
```

```cpp
#include <hip/hip_runtime.h>
#include <cstdio>
#include <cstdint>
namespace pg8 {
#define PG8_LAS __attribute__((address_space(3)))
typedef unsigned short bf16_t;
typedef short bf16x8 __attribute__((ext_vector_type(8)));
typedef float f32x4 __attribute__((ext_vector_type(4)));
typedef unsigned u32x4 __attribute__((ext_vector_type(4)));
constexpr int BM = 256, BK = 64, HALF = 128, HTB = HALF * BK * 2  , STAGE_BYTES = 8 * HTB, NXCD = 8, WGM = 8;

__host__ __device__ __forceinline__ int lds_byte(int r, int c) { const int st = (r >> 4) * 2 + (c >> 5), rr = r & 15, cc = c & 31, ob = rr * 64 + cc * 2; return st * 1024 + (ob ^ (((ob >> 9) & 1) << 5)); }
__host__ __device__ __forceinline__ void stage_rc(int b, int& R, int& C) { const int st = b / 1024, sb = b % 1024, swz = sb ^ (((sb >> 9) & 1) << 5); R = (st >> 1) * 16 + swz / 64; C = (st & 1) * 32 + (swz % 64) / 2; }
__host__ __device__ __forceinline__ int perm32(int rho) { const int n = rho >> 4, i = rho & 15; return 8 * (i >> 2) + 4 * n + (i & 3); }

struct Unit { int pm, pn, koff; };
struct Gemm { const bf16_t* A; const bf16_t* Bt; int M, N, K, ld; };

struct StaticOrder {
    int nM, nN, nwg, G, c;
    __host__ __device__ void init(int M, int N, int G_, int c_) { nM = M / BM; nN = N / BM; nwg = nM * nN; G = G_; c = c_; }
    __host__ __device__ bool next(int i, Unit& u) const {
        const long L = (long)i * G + c; if (L >= nwg) return false;
        int wgid = (int)L; { const int q = nwg / NXCD, r = nwg % NXCD, xcd = wgid % NXCD, off = wgid / NXCD; wgid = (xcd < r ? xcd * (q + 1) : r * (q + 1) + (xcd - r) * q) + off; }
        const int nig = WGM * nN, gid = wgid / nig, fm = gid * WGM, gsz = (nM - fm) < WGM ? (nM - fm) : WGM;
        u.pm = fm + ((wgid % nig) % gsz); u.pn = (wgid % nig) / gsz; u.koff = 0; return true;
    }
    __device__ __forceinline__ void a_ready(const Unit&) const {}
    __device__ __forceinline__ void done(const Unit&) const {}
};

__device__ __forceinline__ unsigned cvt_pk_bf16(float lo, float hi) { unsigned r; asm volatile("v_cvt_pk_bf16_f32 %0, %1, %2" : "=v"(r) : "v"(lo), "v"(hi)); return r; }
template <class Epi, class Sched, bool ALIGN_EPI = false, bool SP2 = false>
__device__ __forceinline__ void gemm_phase(PG8_LAS unsigned char* lds, const Gemm g, const Sched& S, const Epi& E) {
    const int tid = threadIdx.x, wid = __builtin_amdgcn_readfirstlane(tid >> 6), lane = tid & 63, wr = wid >> 2, wc = wid & 3, fr = lane & 15, fq = lane >> 4;
    const int K = g.K, nt = K / BK, LD = g.ld;
    unsigned voffA[2], voffB[2];
#pragma unroll
    for (int i = 0; i < 2; ++i) { int R, C; stage_rc(tid * 16 + i * 8192, R, C); const int Rb = Epi::PERM ? ((R & ~31) + perm32(R & 31)) : R;
        voffA[i] = (unsigned)(R * LD + C) * 2u; voffB[i] = (unsigned)(Rb * LD + C) * 2u; }
    const size_t kstep = (size_t)(BK * 2);
    const size_t hstep = (size_t)HALF * LD * 2;
    const size_t tstep = 2 * hstep;
    const unsigned ldsw = (unsigned)wid * 1024u;
    const int aoff = lds_byte(wr * 64 + fr, fq * 8), boff = lds_byte(wc * 32 + fr, fq * 8);
#define PG8_SA(b, h) (((b) * 2 + (h)) * HTB)
#define PG8_SB(b, h) ((4 + (b) * 2 + (h)) * HTB)
#define PG8_STAGE(bufoff, gbase, voff) do { _Pragma("unroll") for (int _i = 0; _i < 2; ++_i) \
        __builtin_amdgcn_global_load_lds((const unsigned*)((const char*)(gbase) + (voff)[_i]), (PG8_LAS unsigned*)(lds + (bufoff) + ldsw + _i * 8192), 16, 0, 0); } while (0)
#define PG8_LDA(dst, b, h) do { _Pragma("unroll") for (int m = 0; m < 4; ++m) _Pragma("unroll") for (int k = 0; k < 2; ++k) dst[m][k] = *(const PG8_LAS bf16x8*)(lds + PG8_SA(b, h) + aoff + m * 2048 + k * 1024); } while (0)
#define PG8_LDB(dst, b, h) do { _Pragma("unroll") for (int n = 0; n < 2; ++n) _Pragma("unroll") for (int k = 0; k < 2; ++k) dst[n][k] = *(const PG8_LAS bf16x8*)(lds + PG8_SB(b, h) + boff + n * 2048 + k * 1024); } while (0)
#define PG8_MMA(ai, bj, At, Bt) do { __builtin_amdgcn_s_setprio(1); _Pragma("unroll") for (int m = 0; m < 4; ++m) _Pragma("unroll") for (int n = 0; n < 2; ++n) _Pragma("unroll") for (int k = 0; k < 2; ++k) \
        acc[ai][bj][m][n] = __builtin_amdgcn_mfma_f32_16x16x32_bf16(Bt[n][k], At[m][k], acc[ai][bj][m][n], 0, 0, 0); __builtin_amdgcn_s_setprio(0); } while (0)
#define PG8_WAIT_V(n) asm volatile("s_waitcnt vmcnt(" #n ")" ::: "memory")
#define PG8_WAIT_L(n) asm volatile("s_waitcnt lgkmcnt(" #n ")" ::: "memory")
#define PG8_BAR __builtin_amdgcn_s_barrier()
#define PG8_SCHED __builtin_amdgcn_sched_barrier(0)
    Unit cur, nxt; int ui = 0;
    if (!S.next(0, cur)) return;
    f32x4 acc[2][2][4][2];
#pragma unroll
    for (int a = 0; a < 2; ++a)
#pragma unroll
        for (int b = 0; b < 2; ++b)
#pragma unroll
            for (int m = 0; m < 4; ++m)
#pragma unroll
                for (int n = 0; n < 2; ++n) acc[a][b][m][n] = (f32x4){0.f, 0.f, 0.f, 0.f};
    bf16x8 At[4][2], B0[2][2], B1[2][2];
    const char* cA = (const char*)g.A + (size_t)cur.pm * tstep + (size_t)cur.koff * 2; const char* cB = (const char*)g.Bt + (size_t)cur.pn * tstep + (size_t)cur.koff * 2;
    S.a_ready(cur);
    if constexpr (SP2) {
        PG8_STAGE(PG8_SB(0, 0), cB, voffB); PG8_STAGE(PG8_SB(0, 1), cB + hstep, voffB); PG8_STAGE(PG8_SA(0, 0), cA, voffA); PG8_STAGE(PG8_SA(0, 1), cA + hstep, voffA);
        if (wr == 1) PG8_BAR;
        PG8_WAIT_V(2); PG8_BAR;
        PG8_STAGE(PG8_SB(1, 0), cB + kstep, voffB); PG8_STAGE(PG8_SA(1, 0), cA + kstep, voffA); PG8_STAGE(PG8_SB(1, 1), cB + hstep + kstep, voffB);
        PG8_WAIT_V(6); PG8_BAR;
    } else {
        PG8_STAGE(PG8_SB(0, 0), cB, voffB); PG8_STAGE(PG8_SA(0, 0), cA, voffA); PG8_STAGE(PG8_SB(0, 1), cB + hstep, voffB); PG8_STAGE(PG8_SA(0, 1), cA + hstep, voffA);
        if (wr == 1) PG8_BAR;
        PG8_WAIT_V(4); PG8_BAR;
        PG8_STAGE(PG8_SB(1, 0), cB + kstep, voffB); PG8_STAGE(PG8_SA(1, 0), cA + kstep, voffA); PG8_STAGE(PG8_SB(1, 1), cB + hstep + kstep, voffB);
        PG8_WAIT_V(6); PG8_BAR;
    }
    for (;;) {
        const bool has_next = S.next(ui + 1, nxt);
        const char* nA = has_next ? (const char*)g.A + (size_t)nxt.pm * tstep + (size_t)nxt.koff * 2 : cA; const char* nB = has_next ? (const char*)g.Bt + (size_t)nxt.pn * tstep + (size_t)nxt.koff * 2 : cB;
        for (int t = 0; t < nt; t += 2) {
            const bool last = (t == nt - 2);
            const char* a1 = cA + (size_t)(t + 1) * kstep;
            const char* a2 = last ? nA : cA + (size_t)(t + 2) * kstep; const char* b2 = last ? nB : cB + (size_t)(t + 2) * kstep;
            const char* a3 = a2 + kstep; const char* b3 = b2 + kstep;
            if (last && has_next) S.a_ready(nxt);
            if constexpr (SP2) {
            PG8_LDB(B0, 0, 0); PG8_LDB(B1, 0, 1); PG8_SCHED; PG8_LDA(At, 0, 0); PG8_STAGE(PG8_SA(1, 1), a1 + hstep, voffA);
            PG8_WAIT_V(8); PG8_WAIT_L(0); PG8_BAR; PG8_MMA(0, 0, At, B0); PG8_MMA(0, 1, At, B1); PG8_BAR; PG8_SCHED;
            PG8_LDA(At, 0, 1); PG8_STAGE(PG8_SB(0, 0), b2, voffB); PG8_STAGE(PG8_SB(0, 1), b2 + hstep, voffB); PG8_STAGE(PG8_SA(0, 0), a2, voffA);
            PG8_WAIT_V(8); PG8_WAIT_L(0); PG8_BAR; PG8_MMA(1, 0, At, B0); PG8_MMA(1, 1, At, B1); PG8_BAR; PG8_SCHED;
            PG8_LDB(B0, 1, 0); PG8_LDB(B1, 1, 1); PG8_SCHED; PG8_LDA(At, 1, 0); PG8_STAGE(PG8_SA(0, 1), a2 + hstep, voffA);
            PG8_WAIT_V(8); PG8_WAIT_L(0); PG8_BAR; PG8_MMA(0, 0, At, B0); PG8_MMA(0, 1, At, B1); PG8_BAR; PG8_SCHED;
            PG8_LDA(At, 1, 1); PG8_STAGE(PG8_SB(1, 0), b3, voffB); PG8_STAGE(PG8_SB(1, 1), b3 + hstep, voffB); PG8_STAGE(PG8_SA(1, 0), a3, voffA);
            PG8_WAIT_V(8); PG8_WAIT_L(0); PG8_BAR; PG8_MMA(1, 0, At, B0); PG8_MMA(1, 1, At, B1); PG8_BAR; PG8_SCHED;
            } else {
            PG8_LDB(B0, 0, 0); PG8_SCHED; PG8_LDA(At, 0, 0); PG8_STAGE(PG8_SA(1, 1), a1 + hstep, voffA);
            PG8_WAIT_L(8); PG8_BAR; PG8_WAIT_L(0); PG8_MMA(0, 0, At, B0); PG8_BAR; PG8_SCHED;
            PG8_LDB(B1, 0, 1); PG8_STAGE(PG8_SB(0, 0), b2, voffB);
            PG8_BAR; PG8_WAIT_L(0); PG8_MMA(0, 1, At, B1); PG8_BAR;
            PG8_LDA(At, 0, 1); PG8_STAGE(PG8_SA(0, 0), a2, voffA);
            PG8_BAR; PG8_WAIT_L(0); PG8_MMA(1, 0, At, B0); PG8_BAR; PG8_SCHED;
            PG8_STAGE(PG8_SB(0, 1), b2 + hstep, voffB);
            PG8_WAIT_V(6); PG8_BAR; PG8_MMA(1, 1, At, B1); PG8_BAR;
            PG8_LDB(B0, 1, 0); PG8_SCHED; PG8_LDA(At, 1, 0); PG8_STAGE(PG8_SA(0, 1), a2 + hstep, voffA);
            PG8_WAIT_L(8); PG8_BAR; PG8_WAIT_L(0); PG8_MMA(0, 0, At, B0); PG8_BAR; PG8_SCHED;
            PG8_LDB(B1, 1, 1); PG8_STAGE(PG8_SB(1, 0), b3, voffB);
            PG8_BAR; PG8_WAIT_L(0); PG8_MMA(0, 1, At, B1); PG8_BAR;
            PG8_LDA(At, 1, 1); PG8_STAGE(PG8_SA(1, 0), a3, voffA);
            PG8_BAR; PG8_WAIT_L(0); PG8_MMA(1, 0, At, B0); PG8_BAR; PG8_SCHED;
            PG8_STAGE(PG8_SB(1, 1), b3 + hstep, voffB);
            PG8_WAIT_V(6); PG8_BAR; PG8_MMA(1, 1, At, B1); PG8_BAR;
            }
        }
        if constexpr (ALIGN_EPI) { if (wr == 0) PG8_BAR; }
        if constexpr (!Epi::AFTER_DRAIN) { E(acc, cur, wr, wc, fr, fq); S.done(cur); }
        if (!has_next) break;
#pragma unroll
        for (int a = 0; a < 2; ++a)
#pragma unroll
            for (int b = 0; b < 2; ++b)
#pragma unroll
                for (int m = 0; m < 4; ++m)
#pragma unroll
                    for (int n = 0; n < 2; ++n) acc[a][b][m][n] = (f32x4){0.f, 0.f, 0.f, 0.f};
        cur = nxt; cA = nA; cB = nB; ++ui;
        if constexpr (ALIGN_EPI) { if (wr == 1) PG8_BAR; }
    }
    PG8_WAIT_V(0);
    if constexpr (!ALIGN_EPI) { if (wr == 0) PG8_BAR; }
    PG8_BAR;
    if constexpr (Epi::AFTER_DRAIN) { E.fused(acc, cur, wr, wc, fr, fq, lds, wid, lane); S.done(cur); }
#undef PG8_SA
#undef PG8_SB
#undef PG8_STAGE
#undef PG8_LDA
#undef PG8_LDB
#undef PG8_MMA
#undef PG8_WAIT_V
#undef PG8_WAIT_L
#undef PG8_BAR
#undef PG8_SCHED
}
}

using pg8::bf16_t; using pg8::bf16x8; using pg8::f32x4; using pg8::u32x4;
#define LAS __attribute__((address_space(3)))
#define DI __device__ __forceinline__
#define LDS_WAIT() asm volatile("s_waitcnt lgkmcnt(0)" ::: "memory")
typedef unsigned u32x2 __attribute__((ext_vector_type(2)));

constexpr int SEQ = 16384, DM = 1024, NIN = 2048, INW = 1816, FF = 4096;
constexpr float EPS = 1e-6f;
constexpr float LOG2E = 1.4426950408889634f;
constexpr float C2 = 0.125f * LOG2E;
constexpr size_t MiB = 1u << 20;
constexpr size_t WS_MOD = 1 * MiB;
constexpr size_t WS_BIASIN = WS_MOD + 32768;
constexpr size_t WS_BIASFF = WS_BIASIN + 8192;
constexpr size_t WS_BIASC = WS_BIASFF + 16384;
constexpr size_t WS_RSTD1 = WS_BIASC + 2048;
constexpr size_t WS_RSS2 = WS_RSTD1 + 65536;
constexpr size_t WS_G = 2 * MiB;
constexpr size_t WS_KCMP = 4 * MiB;
constexpr size_t WS_VCMPT = 4 * MiB + 262144;
constexpr size_t WS_WPB = 4 * MiB + 524288;
constexpr size_t WS_WINT = 5 * MiB;
constexpr size_t WS_WOUTT = 9 * MiB;
constexpr size_t WS_WFF1T = 11 * MiB;
constexpr size_t WS_WFF2T = 19 * MiB;
constexpr size_t WS_W1CT = 27 * MiB;
constexpr size_t WS_PCMP = 29 * MiB;
constexpr size_t WS_XB = 40 * MiB;
constexpr size_t WS_H = 72 * MiB;
constexpr size_t WS_U = 72 * MiB;
constexpr size_t WS_Q = 88 * MiB;
constexpr size_t WS_ACMP = 104 * MiB;
constexpr size_t WS_KS = 112 * MiB;
constexpr size_t WS_KW = 116 * MiB;
constexpr size_t WS_VST = 120 * MiB;
constexpr size_t WS_VWT = 124 * MiB;
constexpr size_t WS_A2 = 128 * MiB;
constexpr size_t WS_PCMP2 = 200 * MiB;
constexpr size_t WS_END = 216 * MiB;
constexpr int LDS_BYTES = 147456;
constexpr int XCH_OFF = 131072;
constexpr int WAVE_LDS = 17408;

struct Params {
    const float* in[26];
    float* out;
    unsigned char* ws;
    int ph_lo, ph_hi;
};
enum { I_X = 0, I_C, I_WADA, I_BADA, I_N1G, I_N2G, I_WIN, I_WPOOL, I_PSCALE, I_QG, I_KCG, I_KSG, I_KWG,
       I_POSK, I_W1K, I_B1K, I_W2K, I_B2K, I_POSV, I_W1V, I_B1V, I_W2V, I_B2V, I_WOUT, I_WFF1, I_WFF2 };

DI unsigned pk2(float lo, float hi) { return pg8::cvt_pk_bf16(lo, hi); }
DI int kperm(int k, int d) { return ((((k >> 4) * 2 + (d >> 5)) * 16 + (k & 15)) * 4 + ((d >> 3) & 3)) * 8 + (d & 7); }
DI int vperm(int k) { return ((k >> 2) & 3) * 8 + (k >> 4) * 4 + (k & 3); }
DI float bf2f(unsigned short h) { return __uint_as_float((unsigned)h << 16); }
DI float wave_sum(float v) {
#pragma unroll
    for (int o = 1; o < 64; o <<= 1) v += __shfl_xor(v, o);
    return v;
}
DI float wave_max(float v) {
#pragma unroll
    for (int o = 1; o < 64; o <<= 1) v = fmaxf(v, __shfl_xor(v, o));
    return v;
}

DI void gemv_item(const float* v, const float* W, int ldw, int K, int j0, int nvalid, const float* bias, float* out, LAS float* red, int tid) {
    const int c4 = tid & 7, kp = tid >> 3, j = j0 + 4 * c4;
    f32x4 s = {0.f, 0.f, 0.f, 0.f};
    if (j < nvalid) {
#pragma unroll 16
        for (int k = kp; k < K; k += 64) s += *(const f32x4*)(W + (size_t)k * ldw + j) * v[k];
    }
    *(LAS f32x4*)(red + kp * 32 + 4 * c4) = s;
    __syncthreads();
    if (tid < 32) {
        float t = 0.f;
#pragma unroll 16
        for (int i = 0; i < 64; ++i) t += red[i * 32 + tid];
        if (j0 + tid < nvalid) out[j0 + tid] = t + (bias ? bias[j0 + tid] : 0.f);
    }
    __syncthreads();
}

DI void transpose_item(const float* W, int ldw, int k0, int n0, int nvalid, const float* sg, const float* sm, bf16_t* WT, int ldt, int row_off, int col_off, LAS float* scr, int lane) {
    {
        const int n = n0 + 4 * (lane & 7); const bool ok = n < nvalid;
        f32x4 v[8];
#pragma unroll
        for (int i = 0; i < 8; ++i) { const int kk = 8 * i + (lane >> 3); v[i] = ok ? *(const f32x4*)(W + (size_t)(k0 + kk) * ldw + n) : (f32x4){0.f, 0.f, 0.f, 0.f}; }
#pragma unroll
        for (int i = 0; i < 8; ++i) {
            const int kk = 8 * i + (lane >> 3);
            if (sg) v[i] = v[i] * (sg[k0 + kk] * (1.f + sm[k0 + kk]));
            LAS float* d = scr + kk * 33 + 4 * (lane & 7);
            d[0] = v[i][0]; d[1] = v[i][1]; d[2] = v[i][2]; d[3] = v[i][3];
        }
    }
    LDS_WAIT();
    const int c = lane & 7;
#pragma unroll
    for (int j = 0; j < 4; ++j) {
        const int n = (lane >> 3) + 8 * j; const LAS float* s = scr + (8 * c) * 33 + n;
        u32x4 o; o.x = pk2(s[0 * 33], s[1 * 33]); o.y = pk2(s[2 * 33], s[3 * 33]); o.z = pk2(s[4 * 33], s[5 * 33]); o.w = pk2(s[6 * 33], s[7 * 33]);
        *(u32x4*)(WT + (size_t)(row_off + n0 + n) * ldt + col_off + k0 + 8 * c) = o;
    }
    LDS_WAIT();
}

DI void phase0(const Params& p, LAS unsigned char* lds, int tid, int lane, int wave, int G) {
    unsigned char* ws = p.ws;
    float* mod = (float*)(ws + WS_MOD);
    LAS float* red = (LAS float*)(lds + XCH_OFF);
    for (int it = blockIdx.x; it < 192 + 16; it += G) {
        if (it < 192) gemv_item(p.in[I_C], p.in[I_WADA], 6 * DM, DM, it * 32, 6 * DM, p.in[I_BADA], mod, red, tid);
        else { const int r = it - 192, kv = r >> 3, j0 = (r & 7) * 32;
            gemv_item(p.in[kv ? I_POSV : I_POSK], p.in[kv ? I_W1V : I_W1K], 256, 2048, j0, 256, p.in[kv ? I_B1V : I_B1K], (float*)(ws + WS_BIASC) + kv * 256, red, tid); }
    }
    LAS float* scr = (LAS float*)(lds + wave * 16384);
    const int gw = blockIdx.x * 8 + wave, NGW = G * 8;
    constexpr int N_ROWS = SEQ / 4, N_TC = 4 * 128, N_WC = 64, N_Z1 = 512, N_Z2 = 64;
    constexpr int NITEMS = N_ROWS + N_TC + N_WC + N_Z1 + N_Z2;
    for (int it = gw; it < NITEMS; it += NGW) {
        int r = it;
        if (r < N_ROWS) {
            f32x4 v[4][4];
#pragma unroll
            for (int q = 0; q < 4; ++q) { const f32x4* xr = (const f32x4*)(p.in[I_X] + (size_t)(4 * r + q) * DM) + lane;
#pragma unroll
                for (int j = 0; j < 4; ++j) v[q][j] = xr[64 * j]; }
#pragma unroll
            for (int q = 0; q < 4; ++q) {
                float s = 0.f;
#pragma unroll
                for (int j = 0; j < 4; ++j) s += (v[q][j].x * v[q][j].x + v[q][j].y * v[q][j].y) + (v[q][j].z * v[q][j].z + v[q][j].w * v[q][j].w);
                s = wave_sum(s);
                if (lane == 0) ((float*)(ws + WS_RSTD1))[4 * r + q] = rsqrtf(s * (1.f / DM) + EPS);
                u32x2* o8 = (u32x2*)((bf16_t*)(ws + WS_XB) + (size_t)(4 * r + q) * DM) + lane;
#pragma unroll
                for (int j = 0; j < 4; ++j) { u32x2 o; o.x = pk2(v[q][j].x, v[q][j].y); o.y = pk2(v[q][j].z, v[q][j].w); o8[64 * j] = o; }
            }
            continue;
        }
        r -= N_ROWS;
        if (r < N_TC) {
            const int piece = r >> 7, q = r & 127, kv = piece >> 1, half = piece & 1;
            transpose_item(p.in[kv ? I_W1V : I_W1K] + (size_t)half * 1024 * 256, 256, (q >> 3) * 64, (q & 7) * 32, 256, nullptr, nullptr, (bf16_t*)(ws + WS_W1CT), 1024, piece * 256, 0, scr, lane);
            continue;
        }
        r -= N_TC;
        if (r < N_WC) {
#pragma unroll 4
            for (int i = 0; i < 16; ++i) {
                const int idx = r * 1024 + i * 64 + lane, g = idx >> 14, d = (idx >> 7) & 127, c = idx & 127;
                ((bf16_t*)(ws + WS_WPB))[g * 16384 + (((c >> 5) * 8 + (d >> 4)) * 16 + (d & 15)) * 32 + ((c >> 3) & 3) * 8 + (c & 7)] = (bf16_t)(pk2(p.in[I_WPOOL][(size_t)(g * 128 + c) * 128 + d] * p.in[I_PSCALE][g * 128 + d], 0.f) & 0xffffu);
            }
            continue;
        }
        r -= N_WC;
        if (r < N_Z1) { u32x4 z = {0u, 0u, 0u, 0u}; *((u32x4*)(ws + WS_KCMP) + (size_t)r * 64 + lane) = z; continue; }
        r -= N_Z1;
        { u32x4 z = {0u, 0u, 0u, 0u}; *((u32x4*)(ws + WS_RSS2) + (size_t)r * 64 + lane) = z; }
    }
}

DI void phase1(const Params& p, LAS unsigned char* lds, int tid, int lane, int wave, int G) {
    unsigned char* ws = p.ws;
    const float* mod = (const float*)(ws + WS_MOD);
    LAS float* red = (LAS float*)(lds + XCH_OFF);
    for (int it = blockIdx.x; it < 57; it += G) gemv_item(mod + 0, p.in[I_WIN], INW, DM, it * 32, INW, nullptr, (float*)(ws + WS_BIASIN), red, tid);
    LAS float* scr = (LAS float*)(lds + wave * 16384);
    const int gw = ((blockIdx.x + 199) % G) * 8 + wave, NGW = G * 8;
    for (int it = gw; it < 16 * 57; it += NGW)
        transpose_item(p.in[I_WIN], INW, (it / 57) * 64, (it % 57) * 32, INW, p.in[I_N1G], mod + 1 * DM, (bf16_t*)(ws + WS_WINT), DM, 0, 0, scr, lane);
}
#define XB_TMO      128
#define XB_XCNT(j)  (256  + 64 * (j))
#define XB_XSUB(j)  (1280 + 64 * (j))
#define XB_XGEN(j)  (2304 + 64 * (j))
#define XB_TOP      3328
#define XB_TOPGEN   3392
#define XCD_BAR_WORDS 3456
#define XB_SPIN_CAP (1u << 18)

__device__ __forceinline__ unsigned xb_ld(unsigned* p)              { return __hip_atomic_load(p, __ATOMIC_RELAXED, __HIP_MEMORY_SCOPE_AGENT); }
__device__ __forceinline__ unsigned xb_add(unsigned* p, unsigned v) { return __hip_atomic_fetch_add(p, v, __ATOMIC_RELAXED, __HIP_MEMORY_SCOPE_AGENT); }
__device__ __forceinline__ unsigned xb_xcc_id() { return (unsigned)__builtin_amdgcn_s_getreg((3 << 11) | 20) & 0xFu; }
#define XB_SPIN(cond, bar) do { unsigned _sp = 0; while (cond) { __builtin_amdgcn_s_sleep(1); \
    if ((++_sp & 255u) == 0u) { if (xb_ld(&(bar)[XB_TMO])) break; if (_sp > XB_SPIN_CAP) { atomicAdd(&(bar)[XB_TMO], 1u); break; } } } } while (0)

struct XcdBarrier {
    unsigned* bar; unsigned x;
    volatile LAS unsigned* st;
};

__device__ __forceinline__ XcdBarrier xcd_barrier_post(unsigned* bar, volatile LAS unsigned* st) {
    XcdBarrier b; b.bar = bar; b.x = xb_xcc_id(); b.st = st;
    if (threadIdx.x == 0) (void)xb_add(&bar[XB_XCNT(b.x)], 1u);
    return b;
}
__device__ __forceinline__ void xcd_barrier_complete(unsigned* bar, unsigned x, unsigned& nloc, unsigned& nx) {
    const unsigned G = gridDim.x * gridDim.y * gridDim.z;
    unsigned sum, cnt, mine, sp = 0u;
    for (;;) {
        sum = 0u; cnt = 0u; mine = 0u;
#pragma unroll
        for (unsigned j = 0; j < 16; ++j) { const unsigned c = xb_ld(&bar[XB_XCNT(j)]); sum += c; cnt += (c > 0u) ? 1u : 0u; mine = (j == x) ? c : mine; }
        if (sum == G) break;
        __builtin_amdgcn_s_sleep(1);
        if ((++sp & 255u) == 0u) { if (xb_ld(&bar[XB_TMO])) break; if (sp > XB_SPIN_CAP) { atomicAdd(&bar[XB_TMO], 1u); break; } }
    }
    nloc = mine > 0u ? mine : 1u; nx = cnt > 0u ? cnt : 1u;
}

__device__ __forceinline__ void xcd_barrier(const XcdBarrier& b) {
    asm volatile("s_waitcnt vmcnt(0)" ::: "memory");
    __syncthreads();
    if (threadIdx.x == 0) {
        unsigned* bar = b.bar;
        __builtin_amdgcn_s_waitcnt(0);
        unsigned nloc = b.st[0], nx = b.st[1];
        if (nloc == 0u) { xcd_barrier_complete(bar, b.x, nloc, nx); b.st[0] = nloc; b.st[1] = nx; }
        const unsigned old = xb_add(&bar[XB_XSUB(b.x)], 1u);
        const unsigned gen = old / nloc;
        if (old + 1u == (gen + 1u) * nloc) {
            __builtin_amdgcn_fence(__ATOMIC_RELEASE, "agent");
            asm volatile("s_waitcnt vmcnt(0)" ::: "memory");
            const unsigned og = xb_add(&bar[XB_TOP], 1u);
            const unsigned tg = og / nx;
            if (og + 1u == (tg + 1u) * nx) xb_add(&bar[XB_TOPGEN], 1u);
            else XB_SPIN(xb_ld(&bar[XB_TOPGEN]) == tg, bar);
            __builtin_amdgcn_fence(__ATOMIC_ACQUIRE, "agent");
            xb_add(&bar[XB_XGEN(b.x)], 1u);
            asm volatile("s_waitcnt vmcnt(0)" ::: "memory");
        } else {
            XB_SPIN(xb_ld(&bar[XB_XGEN(b.x)]) == gen, bar);
            __builtin_amdgcn_fence(__ATOMIC_ACQUIRE, "agent");
            asm volatile("s_waitcnt vmcnt(0)" ::: "memory");
        }
    }
    __syncthreads();
}

DI u32x4 pack8(const f32x4& a, const f32x4& b) { u32x4 w; w.x = pk2(a[0], a[1]); w.y = pk2(a[2], a[3]); w.z = pk2(b[0], b[1]); w.w = pk2(b[2], b[3]); return w; }

struct EpiIn {
    static constexpr bool PERM = true, AFTER_DRAIN = false;
    const float* rstd1; const float* bias; const float* q_gain; const float* ks_gain; const float* kw_gain;
    bf16_t *U, *Q, *ACMP, *KS, *KW, *VST, *VWT; float* G; LAS float* xch;
    DI void operator()(const f32x4 (&acc)[2][2][4][2], const pg8::Unit& u, int wr, int wc, int fr, int fq_in) const {
        const int pn = u.pn, wid = wr * 4 + wc;
        int fq = fq_in; asm volatile("" : "+v"(fq));
        int row0 = u.pm * 256 + wr * 64 + fr, colb = pn * 256 + wc * 32 + 8 * fq;
        asm volatile("" : "+v"(row0), "+v"(colb));
        const int gsel = wc >> 1, d0 = (wc & 1) * 32 + 8 * fq;
#pragma unroll
        for (int bj = 0; bj < 2; ++bj) {
            float ss[2][4];
#pragma unroll
            for (int ai = 0; ai < 2; ++ai)
#pragma unroll
                for (int m = 0; m < 4; ++m) ss[ai][m] = 0.f;
            const bool need_norm = (pn == 2) || (pn == 3) || ((pn == 5 || pn == 6) && bj == 0);
            if (need_norm) {
#pragma unroll
            for (int ai = 0; ai < 2; ++ai)
#pragma unroll
                for (int m = 0; m < 4; ++m) {
                    const float rsv = rstd1[row0 + ai * 128 + m * 16];
                    const f32x4 v0 = acc[ai][bj][m][0] * rsv + *(const f32x4*)(bias + colb + bj * 128), v1 = acc[ai][bj][m][1] * rsv + *(const f32x4*)(bias + colb + bj * 128 + 4);
                    float s = (v0[0] * v0[0] + v0[1] * v0[1]) + (v0[2] * v0[2] + v0[3] * v0[3]) + (v1[0] * v1[0] + v1[1] * v1[1]) + (v1[2] * v1[2] + v1[3] * v1[3]);
                    s += __shfl_xor(s, 16); s += __shfl_xor(s, 32);
                    ss[ai][m] = s;
                }
            if (fq == 0) {
#pragma unroll
                for (int ai = 0; ai < 2; ++ai)
#pragma unroll
                    for (int m = 0; m < 4; ++m) xch[wid * 256 + ((bj * 2 + ai) * 4 + m) * 16 + fr] = ss[ai][m];
            }
            LDS_WAIT(); __builtin_amdgcn_s_barrier(); asm volatile("" ::: "memory");
#pragma unroll
            for (int ai = 0; ai < 2; ++ai)
#pragma unroll
                for (int m = 0; m < 4; ++m) ss[ai][m] += xch[(wid ^ 1) * 256 + ((bj * 2 + ai) * 4 + m) * 16 + fr];
            }
#pragma unroll
            for (int ai = 0; ai < 2; ++ai)
#pragma unroll
                for (int m = 0; m < 4; ++m) {
                    const int row = row0 + ai * 128 + m * 16;
                    const float rsv = rstd1[row];
                    f32x4 v0 = acc[ai][bj][m][0] * rsv + *(const f32x4*)(bias + colb + bj * 128), v1 = acc[ai][bj][m][1] * rsv + *(const f32x4*)(bias + colb + bj * 128 + 4);
                    if (pn < 2) {
                        *(u32x4*)(U + ((((size_t)(row >> 4) * 4 + (pn * 2 + bj)) * 4 + wc) * 16 + (row & 15)) * 32 + 8 * fq) = pack8(v0, v1);
                    } else if (pn < 4) {
                        const float rn = rsqrtf(ss[ai][m] * (1.f / 64.f) + EPS);
                        const f32x4 g0 = *(const f32x4*)(q_gain + d0), g1 = *(const f32x4*)(q_gain + d0 + 4);
                        v0 = v0 * (rn * C2) * g0; v1 = v1 * (rn * C2) * g1;
                        *(u32x4*)(Q + (size_t)row * 512 + (pn - 2) * 256 + bj * 128 + wc * 32 + 8 * fq) = pack8(v0, v1);
                    } else if (pn == 4) {
                        *(u32x4*)(ACMP + ((size_t)(bj * 2 + gsel) * SEQ + row) * 64 + d0) = pack8(v0, v1);
                    } else if (pn < 7) {
                        if (bj == 0) {
                            const float* gain = (pn == 5) ? ks_gain : kw_gain;
                            const float rn = rsqrtf(ss[ai][m] * (1.f / 64.f) + EPS);
                            const f32x4 g0 = *(const f32x4*)(gain + d0), g1 = *(const f32x4*)(gain + d0 + 4);
                            v0 = v0 * rn * g0; v1 = v1 * rn * g1;
                            bf16_t* K = (pn == 5) ? KS : KW;
                            *(u32x4*)(K + ((size_t)gsel * SEQ + (row & ~31)) * 64 + kperm(row & 31, d0)) = pack8(v0, v1);
                        } else {
                            bf16_t* VT = ((pn == 5) ? VST : VWT) + (((size_t)gsel * 512 + (row >> 5)) * 64 + d0) * 32 + vperm(row & 31);
                            const u32x4 w = pack8(v0, v1);
                            VT[0 * 32] = (bf16_t)(w.x & 0xffffu); VT[1 * 32] = (bf16_t)(w.x >> 16); VT[2 * 32] = (bf16_t)(w.y & 0xffffu); VT[3 * 32] = (bf16_t)(w.y >> 16);
                            VT[4 * 32] = (bf16_t)(w.z & 0xffffu); VT[5 * 32] = (bf16_t)(w.z >> 16); VT[6 * 32] = (bf16_t)(w.w & 0xffffu); VT[7 * 32] = (bf16_t)(w.w >> 16);
                        }
                    } else {
                        if (bj == 0 && wc == 0 && fq < 3) {
                            f32x4 s0, s1;
#pragma unroll
                            for (int i = 0; i < 4; ++i) { s0[i] = __builtin_amdgcn_rcpf(1.f + __expf(-v0[i])); s1[i] = __builtin_amdgcn_rcpf(1.f + __expf(-v1[i])); }
                            *(f32x4*)(G + (size_t)row * 24 + 8 * fq) = s0; *(f32x4*)(G + (size_t)row * 24 + 8 * fq + 4) = s1;
                        }
                    }
                }
        }
    }
};

struct EpiCmp {
    static constexpr bool PERM = true, AFTER_DRAIN = false;
    float* P;
    DI void operator()(const f32x4 (&acc)[2][2][4][2], const pg8::Unit& u, int wr, int wc, int fr, int fq) const {
        const int row0 = u.pm * 256 + wr * 64 + fr, col0 = (u.pn & 1) * 256 + wc * 32 + 8 * fq;
#pragma unroll
        for (int ai = 0; ai < 2; ++ai)
#pragma unroll
            for (int m = 0; m < 4; ++m)
#pragma unroll
                for (int bj = 0; bj < 2; ++bj) {
                    float* dst = P + (u.koff ? (size_t)4096 * 512 : (size_t)0) + (size_t)(row0 + ai * 128 + m * 16) * 512 + col0 + bj * 128;
                    *(f32x4*)dst = acc[ai][bj][m][0]; *(f32x4*)(dst + 4) = acc[ai][bj][m][1];
                }
    }
};
struct CmpOrder {
    int G, c;
    DI bool next(int i, pg8::Unit& u) const { const long L = (long)i * G + c; if (L >= 64) return false; const int r = (int)L & 31; u.pm = r >> 1; u.pn = (r & 1) + 2 * (u.pm >> 3); u.koff = ((int)L >> 5) * 512; return true; }
    DI void a_ready(const pg8::Unit&) const {}
    DI void done(const pg8::Unit&) const {}
};

struct EpiOut {
    static constexpr bool PERM = true, AFTER_DRAIN = false;
    const float* x; const float* ga1; float* out; bf16_t* X1b; float* rss2;
    DI void operator()(const f32x4 (&acc)[2][2][4][2], const pg8::Unit& u, int wr, int wc, int fr, int fq) const {
        const int row0 = u.pm * 256 + wr * 64 + fr, col0 = u.pn * 256 + wc * 32 + 8 * fq;
        f32x4 gv[2][2];
#pragma unroll
        for (int bj = 0; bj < 2; ++bj)
#pragma unroll
            for (int n = 0; n < 2; ++n) gv[bj][n] = *(const f32x4*)(ga1 + col0 + bj * 128 + 4 * n);
#pragma unroll
        for (int ai = 0; ai < 2; ++ai)
#pragma unroll
            for (int m = 0; m < 4; ++m) {
                const int row = row0 + ai * 128 + m * 16; float s = 0.f;
#pragma unroll
                for (int bj = 0; bj < 2; ++bj) {
                    const size_t off = (size_t)row * DM + col0 + bj * 128;
                    const u32x4 xb = *(const u32x4*)(X1b + off);
                    const f32x4 x0 = {__uint_as_float(xb.x << 16), __uint_as_float(xb.x & 0xffff0000u), __uint_as_float(xb.y << 16), __uint_as_float(xb.y & 0xffff0000u)};
                    const f32x4 x1 = {__uint_as_float(xb.z << 16), __uint_as_float(xb.z & 0xffff0000u), __uint_as_float(xb.w << 16), __uint_as_float(xb.w & 0xffff0000u)};
                    const f32x4 v0 = x0 + gv[bj][0] * acc[ai][bj][m][0], v1 = x1 + gv[bj][1] * acc[ai][bj][m][1];
                    *(u32x4*)(X1b + off) = pack8(v0, v1);
                    s += (v0[0] * v0[0] + v0[1] * v0[1]) + (v0[2] * v0[2] + v0[3] * v0[3]) + (v1[0] * v1[0] + v1[1] * v1[1]) + (v1[2] * v1[2] + v1[3] * v1[3]);
                }
                s += __shfl_xor(s, 16); s += __shfl_xor(s, 32);
                if (fq == 0) atomicAdd(rss2 + row, s);
            }
    }
};

struct EpiFF1 {
    static constexpr bool PERM = true, AFTER_DRAIN = false;
    const float* rss2; const float* bias; bf16_t* H;
    DI void operator()(const f32x4 (&acc)[2][2][4][2], const pg8::Unit& u, int wr, int wc, int fr, int fq) const {
        const int row0 = u.pm * 256 + wr * 64 + fr, col0 = u.pn * 256 + wc * 32 + 8 * fq;
        f32x4 bv[2][2];
#pragma unroll
        for (int bj = 0; bj < 2; ++bj)
#pragma unroll
            for (int n = 0; n < 2; ++n) bv[bj][n] = *(const f32x4*)(bias + col0 + bj * 128 + 4 * n);
#pragma unroll
        for (int ai = 0; ai < 2; ++ai)
#pragma unroll
            for (int m = 0; m < 4; ++m) {
                const int row = row0 + ai * 128 + m * 16;
                const float rs = rsqrtf(rss2[row] * (1.f / DM) + EPS);
#pragma unroll
                for (int bj = 0; bj < 2; ++bj) {
                    f32x4 v0 = acc[ai][bj][m][0] * rs + bv[bj][0], v1 = acc[ai][bj][m][1] * rs + bv[bj][1];
#pragma unroll
                    for (int i = 0; i < 4; ++i) { const float a = fmaxf(v0[i], 0.f), b = fmaxf(v1[i], 0.f); v0[i] = a * a; v1[i] = b * b; }
                    *(u32x4*)(H + (size_t)row * FF + col0 + bj * 128) = pack8(v0, v1);
                }
            }
    }
};

struct EpiFF2 {
    static constexpr bool PERM = true, AFTER_DRAIN = false;
    const float* ga2; float* out; const bf16_t* X1b;
    DI void operator()(const f32x4 (&acc)[2][2][4][2], const pg8::Unit& u, int wr, int wc, int fr, int fq) const {
        const int row0 = u.pm * 256 + wr * 64 + fr, col0 = u.pn * 256 + wc * 32 + 8 * fq;
        f32x4 gv[2][2];
#pragma unroll
        for (int bj = 0; bj < 2; ++bj)
#pragma unroll
            for (int n = 0; n < 2; ++n) gv[bj][n] = *(const f32x4*)(ga2 + col0 + bj * 128 + 4 * n);
#pragma unroll
        for (int ai = 0; ai < 2; ++ai)
#pragma unroll
            for (int m = 0; m < 4; ++m)
#pragma unroll
                for (int bj = 0; bj < 2; ++bj) {
                    const size_t off = (size_t)(row0 + ai * 128 + m * 16) * DM + col0 + bj * 128;
                    float* dst = out + off;
                    const u32x4 xb = *(const u32x4*)(X1b + off);
                    const f32x4 x0 = {__uint_as_float(xb.x << 16), __uint_as_float(xb.x & 0xffff0000u), __uint_as_float(xb.y << 16), __uint_as_float(xb.y & 0xffff0000u)};
                    const f32x4 x1 = {__uint_as_float(xb.z << 16), __uint_as_float(xb.z & 0xffff0000u), __uint_as_float(xb.w << 16), __uint_as_float(xb.w & 0xffff0000u)};
                    *(f32x4*)dst = x0 + gv[bj][0] * acc[ai][bj][m][0]; *(f32x4*)(dst + 4) = x1 + gv[bj][1] * acc[ai][bj][m][1];
                }
    }
};

template <int CTRL> DI float dpp_f(float x) {
    return __uint_as_float((unsigned)__builtin_amdgcn_update_dpp(0, (int)__float_as_uint(x), CTRL, 0xF, 0xF, true));
}
DI float row_scan(float x) {
    x += dpp_f<0x111>(x); x += dpp_f<0x112>(x); x += dpp_f<0x114>(x); x += dpp_f<0x118>(x);
    return x;
}
DI void unpack8(const u32x4& v, float (&f)[8]) {
    f[0] = __uint_as_float(v.x << 16); f[1] = __uint_as_float(v.x & 0xffff0000u); f[2] = __uint_as_float(v.y << 16); f[3] = __uint_as_float(v.y & 0xffff0000u);
    f[4] = __uint_as_float(v.z << 16); f[5] = __uint_as_float(v.z & 0xffff0000u); f[6] = __uint_as_float(v.w << 16); f[7] = __uint_as_float(v.w & 0xffff0000u);
}
template <int W>
DI void pool_item(const Params& p, int tile, int g, int lane) {
    const bf16_t* U = (const bf16_t*)(p.ws + WS_U);
    bf16_t* A2 = (bf16_t*)(p.ws + WS_A2);
    const int tl = lane & 15, quad = lane >> 4, t = tile * 16 + tl;
    const int cnt = (t + 1) < W ? (t + 1) : W;
    const float inv = 1.f / (float)cnt;
    const bf16_t* WpB = (const bf16_t*)(p.ws + WS_WPB) + (size_t)g * 128 * 128;
    f32x4 acc[8];
#pragma unroll
    for (int nt = 0; nt < 8; ++nt) acc[nt] = (f32x4){0.f, 0.f, 0.f, 0.f};
    const int lane15 = ((lane & 48) | 15) << 2;
    const bf16_t* ub = U + ((size_t)tile * 4 + g) * 2048 + tl * 32 + quad * 8;
    u32x4 vcn = *(const u32x4*)ub;
    u32x4 vpn = (tile > 0) ? *(const u32x4*)(ub - 8192) : (u32x4){0u, 0u, 0u, 0u};
#pragma unroll 1
    for (int ks = 0; ks < 4; ++ks) {
        const u32x4 vcc = vcn, vpp = vpn;
        const int kn = (ks < 3) ? ks + 1 : ks;
        vcn = *(const u32x4*)(ub + kn * 512);
        vpn = (tile > 0) ? *(const u32x4*)(ub - 8192 + kn * 512) : (u32x4){0u, 0u, 0u, 0u};
        bf16x8 wf[8];
#pragma unroll
        for (int nt = 0; nt < 8; ++nt) wf[nt] = *(const bf16x8*)(WpB + (size_t)(ks * 8 + nt) * 512 + tl * 32 + quad * 8);
        float c[8], q[8], r[8];
        unpack8(vcc, c); unpack8(vpp, q);
#pragma unroll
        for (int e = 0; e < 8; ++e) {
            const float pc = row_scan(c[e]), pp = row_scan(q[e]);
            const float tot = __uint_as_float((unsigned)__builtin_amdgcn_ds_bpermute(lane15, (int)__float_as_uint(pp)));
            float inside = pc, ppw = pp;
            if constexpr (W < 16) {
                inside = pc - dpp_f<0x110 + W>(pc);
                ppw = dpp_f<0x100 + (16 - W)>(pp);
            }
            const float before = (tl < W) ? (tot - ppw) : 0.f;
            r[e] = (inside + before) * inv - c[e];
        }
        u32x4 o; o.x = pk2(r[0], r[1]); o.y = pk2(r[2], r[3]); o.z = pk2(r[4], r[5]); o.w = pk2(r[6], r[7]);
        const bf16x8 pf = __builtin_bit_cast(bf16x8, o);
#pragma unroll
        for (int nt = 0; nt < 8; ++nt) acc[nt] = __builtin_amdgcn_mfma_f32_16x16x32_bf16(wf[nt], pf, acc[nt], 0, 0, 0);
    }
#pragma unroll
    for (int nt = 0; nt < 8; ++nt) {
        u32x2 o; o.x = pk2(acc[nt][0], acc[nt][1]); o.y = pk2(acc[nt][2], acc[nt][3]);
        *(u32x2*)(A2 + (size_t)t * DM + g * 128 + nt * 16 + 4 * quad) = o;
    }
}
DI void side_items(const Params& p, LAS unsigned char* lds, int lane, int wave, int slot, int nslots, int p_lo, int p_hi, int t_lo, int t_hi) {
    unsigned char* ws = p.ws;
    const float* mod = (const float*)(ws + WS_MOD);
    LAS float* scr = (LAS float*)(lds + wave * 16384);
    for (int r = p_lo + slot; r < p_hi; r += nslots) {
        const int g = 3 - (r >> 10), tile = r & 1023;
        if (g == 0) pool_item<2>(p, tile, 0, lane);
        else if (g == 1) pool_item<4>(p, tile, 1, lane);
        else if (g == 2) pool_item<8>(p, tile, 2, lane);
        else pool_item<16>(p, tile, 3, lane);
    }
    constexpr int N_T1 = 16 * 128, N_T2 = 64 * 32;
    for (int it = t_lo + slot; it < t_hi; it += nslots) {
        int r = it;
        if (r < N_T1) { transpose_item(p.in[I_WFF1], FF, (r >> 7) * 64, (r & 127) * 32, FF, p.in[I_N2G], mod + 4 * DM, (bf16_t*)(ws + WS_WFF1T), DM, 0, 0, scr, lane); continue; }
        r -= N_T1;
        if (r < N_T2) { transpose_item(p.in[I_WFF2], DM, (r >> 5) * 64, (r & 31) * 32, DM, nullptr, nullptr, (bf16_t*)(ws + WS_WFF2T), FF, 0, 0, scr, lane); continue; }
        r -= N_T2;
        transpose_item(p.in[I_WOUT], DM, (r >> 5) * 64, (r & 31) * 32, DM, nullptr, nullptr, (bf16_t*)(ws + WS_WOUTT), DM, 0, 0, scr, lane);
    }
}
constexpr int SIDE_P_SPLIT = 3840, SIDE_T_SPLIT = 4224, SIDE_T_ALL = 16 * 128 + 64 * 32 + 16 * 32;
DI void side_phase(const Params& p, LAS unsigned char* lds, int tid, int lane, int wave, int G) {
    const int nb = G - 64, bid = blockIdx.x - 64;
    LAS float* red = (LAS float*)(lds + XCH_OFF);
    for (int it = bid; it < 128; it += nb) gemv_item((const float*)(p.ws + WS_MOD) + 3 * DM, p.in[I_WFF1], FF, DM, it * 32, FF, nullptr, (float*)(p.ws + WS_BIASFF), red, tid);
    side_items(p, lds, lane, wave, ((bid + 64) % nb) * 8 + wave, nb * 8, 0, SIDE_P_SPLIT, 0, SIDE_T_SPLIT);
}

DI void phase4(const Params& p, LAS unsigned char* lds, int tid, int lane, int wave, int G) {
    unsigned char* ws = p.ws;
    const float* P = (const float*)(ws + WS_PCMP2);
    const float* biasc = (const float*)(ws + WS_BIASC);
    const int kv = blockIdx.x & 1;
    LAS float* w2s = (LAS float*)lds;
    LAS float* hb = (LAS float*)(lds + 65536 + wave * 1024);
    {
        const f32x4* src = (const f32x4*)p.in[kv ? I_W2V : I_W2K];
#pragma unroll
        for (int i = 0; i < 8; ++i) ((LAS f32x4*)w2s)[i * 512 + tid] = src[i * 512 + tid];
    }
    __syncthreads();
    const float b2 = p.in[kv ? I_B2V : I_B2K][lane];
    const int nbw = (G >> 1) * 8;
    for (int r = (blockIdx.x >> 1) * 8 + wave; r < 2 * 1023; r += nbw) {
        const int g = r / 1023, n = r - g * 1023, kvg = kv * 2 + g;
        const float* p0 = P + (size_t)(kvg * 1024 + n) * 512;
#pragma unroll
        for (int i = 0; i < 4; ++i) {
            const int j = lane + 64 * i;
            const float x = (p0[j] + p0[(size_t)4096 * 512 + j]) + (p0[512 + 256 + j] + p0[(size_t)4096 * 512 + 512 + 256 + j]) + biasc[kv * 256 + j];
            const float t = tanhf(0.7978845608028654f * (x + 0.044715f * x * x * x));
            hb[j] = 0.5f * x * (1.f + t);
        }
        LDS_WAIT();
        float o = b2;
#pragma unroll 8
        for (int j4 = 0; j4 < 64; ++j4) {
            const f32x4 h = *(const LAS f32x4*)(hb + 4 * j4);
            o += h[0] * w2s[(4 * j4 + 0) * 64 + lane]; o += h[1] * w2s[(4 * j4 + 1) * 64 + lane];
            o += h[2] * w2s[(4 * j4 + 2) * 64 + lane]; o += h[3] * w2s[(4 * j4 + 3) * 64 + lane];
        }
        if (kv == 0) {
            const float ss = wave_sum(o * o);
            const float y = o * rsqrtf(ss * (1.f / 64.f) + EPS) * p.in[I_KCG][lane];
            ((bf16_t*)(ws + WS_KCMP))[((size_t)g * 1024 + (n & ~31)) * 64 + kperm(n & 31, lane)] = (bf16_t)(pk2(y, 0.f) & 0xffffu);
        } else {
            ((bf16_t*)(ws + WS_VCMPT))[(((size_t)g * 32 + (n >> 5)) * 64 + lane) * 32 + vperm(n & 31)] = (bf16_t)(pk2(o, 0.f) & 0xffffu);
        }
        LDS_WAIT();
    }
}

#define MFMA16(a, b, c) __builtin_amdgcn_mfma_f32_16x16x32_bf16((a), (b), (c), 0, 0, 0)

DI void load_k(const bf16_t* kbase, bf16x8 (&kf)[2][2], int tl, int quad) {
#ifdef PROBE_HOT
    kbase = (const bf16_t*)((uintptr_t)kbase & ~(uintptr_t)0xFFF000);
#endif
#pragma unroll
    for (int ks = 0; ks < 2; ++ks)
#pragma unroll
        for (int dh = 0; dh < 2; ++dh) kf[ks][dh] = *(const bf16x8*)(kbase + (((ks * 2 + dh) * 16 + tl) * 4 + quad) * 8);
}
template <int HFC = 0>
DI void qk_mma(const bf16x8 (&kf)[2][2], const bf16x8 (&qf)[4][2], f32x4 (&s)[4][2]) {
#pragma unroll
    for (int h = HFC; h < 4; ++h)
#pragma unroll
        for (int ks = 0; ks < 2; ++ks) {
            s[h][ks] = MFMA16(kf[ks][0], qf[h][0], s[h][ks]);
            s[h][ks] = MFMA16(kf[ks][1], qf[h][1], s[h][ks]);
        }
}
DI void load_v(const bf16_t* vt, bf16x8 (&vf)[4], int tl, int quad) {
#ifdef PROBE_HOT
    vt = (const bf16_t*)((uintptr_t)vt & ~(uintptr_t)0xFFF000);
#endif
#pragma unroll
    for (int dt = 0; dt < 4; ++dt) {
        vf[dt] = *(const bf16x8*)(vt + (dt * 16 + tl) * 32 + 8 * quad);
    }
}
template <int HFC = 0>
DI void pv_mma(const bf16x8 (&vf)[4], const bf16x8 (&pb)[4], f32x4 (&o)[4][4]) {
#pragma unroll
    for (int dt = 0; dt < 4; ++dt)
#pragma unroll
        for (int h = HFC; h < 4; ++h) o[h][dt] = MFMA16(vf[dt], pb[h], o[h][dt]);
}
template <int HFC = 0>
DI void pv_tile(const bf16_t* vt, const bf16x8 (&pb)[4], f32x4 (&o)[4][4], int tl, int quad) {
#pragma unroll
    for (int hf = 0; hf < 2; ++hf) {
        bf16x8 vf[2];
#pragma unroll
        for (int d2 = 0; d2 < 2; ++d2) {
            const int dt = hf * 2 + d2;
            vf[d2] = *(const bf16x8*)(vt + (dt * 16 + tl) * 32 + 8 * quad);
        }
#pragma unroll
        for (int d2 = 0; d2 < 2; ++d2)
#pragma unroll
            for (int h = HFC; h < 4; ++h) o[h][hf * 2 + d2] = MFMA16(vf[d2], pb[h], o[h][hf * 2 + d2]);
    }
}
DI void l_mma(const bf16x8 (&pb)[4], f32x4 (&la)[4]) {
    u32x4 w1 = {0x3F803F80u, 0x3F803F80u, 0x3F803F80u, 0x3F803F80u};
    const bf16x8 ones = __builtin_bit_cast(bf16x8, w1);
#pragma unroll
    for (int h = 0; h < 4; ++h) la[h] = MFMA16(ones, pb[h], la[h]);
}
template <int STRIDE, int HFC = 0>
DI void bias_init(f32x4 (&s)[4][2], const float (&sl2)[4], const float (&ref)[4], int dbase) {
    const float nd0 = (float)(-dbase);
    float nd[2][4];
#pragma unroll
    for (int ks = 0; ks < 2; ++ks)
#pragma unroll
        for (int i = 0; i < 4; ++i) nd[ks][i] = (float)(STRIDE * (16 * ks + i)) + nd0;
#pragma unroll
    for (int h = HFC; h < 4; ++h)
#pragma unroll
        for (int ks = 0; ks < 2; ++ks)
#pragma unroll
            for (int i = 0; i < 4; ++i) s[h][ks][i] = fmaf(sl2[h], nd[ks][i], -ref[h]);
}
template <int STRIDE, int HFC = 0>
DI void exp_tile(f32x4 (&s)[4][2], int dbase, unsigned lim) {
    const bool allok = ((unsigned)(dbase - 19 * STRIDE) < lim) && ((unsigned)dbase < lim);
    if (__all(allok)) {
#pragma unroll
        for (int h = HFC; h < 4; ++h)
#pragma unroll
            for (int ks = 0; ks < 2; ++ks)
#pragma unroll
                for (int i = 0; i < 4; ++i) s[h][ks][i] = __builtin_amdgcn_exp2f(s[h][ks][i]);
    } else {
        bool ok[2][4];
#pragma unroll
        for (int ks = 0; ks < 2; ++ks)
#pragma unroll
            for (int i = 0; i < 4; ++i) ok[ks][i] = (unsigned)(dbase - STRIDE * (16 * ks + i)) < lim;
#pragma unroll
        for (int h = HFC; h < 4; ++h)
#pragma unroll
            for (int ks = 0; ks < 2; ++ks)
#pragma unroll
                for (int i = 0; i < 4; ++i) { const float e = __builtin_amdgcn_exp2f(s[h][ks][i]); s[h][ks][i] = ok[ks][i] ? e : 0.f; }
    }
}
template <int HFC = 0>
DI void lsum(const f32x4 (&s)[4][2], float (&l)[4]) {
#pragma unroll
    for (int h = HFC; h < 4; ++h) { const f32x4 t = s[h][0] + s[h][1]; l[h] += (t[0] + t[1]) + (t[2] + t[3]); }
}
template <int HFC = 0>
DI void pack_tile(const f32x4 (&s)[4][2], bf16x8 (&pb)[4]) {
#pragma unroll
    for (int h = HFC; h < 4; ++h) pb[h] = __builtin_bit_cast(bf16x8, pack8(s[h][0], s[h][1]));
}
DI void list_insert(unsigned (&lst)[16], unsigned key) {
#pragma unroll
    for (int i = 0; i < 16; ++i) { const unsigned hi = lst[i] > key ? lst[i] : key, lo = lst[i] > key ? key : lst[i]; lst[i] = hi; key = lo; }
}

DI void attn_unit(const Params& p, int tile, int g, int lane, LAS unsigned char* wl, float ref_c, float ref_s, float ref_w, int mode, LAS unsigned char* pl) {
    unsigned char* ws = p.ws;
    const int t0 = tile * 16, tl = lane & 15, quad = lane >> 4, tok = t0 + tl, cur = t0 >> 6;
    LAS f32x4* fin = (LAS f32x4*)wl;
    LAS unsigned* lstx = (LAS unsigned*)wl;
    LAS unsigned* keysL = (LAS unsigned*)wl;
    LAS unsigned* msk = (LAS unsigned*)(wl + 16512);
    LAS unsigned* uni = msk + 128;
    LAS unsigned char* ulist = (LAS unsigned char*)(uni + 8);
    const bf16_t* Q = (const bf16_t*)(ws + WS_Q);
    const bf16_t* KC = (const bf16_t*)(ws + WS_KCMP) + (size_t)g * 1024 * 64;
    const bf16_t* VCT = (const bf16_t*)(ws + WS_VCMPT) + (size_t)g * 32 * 64 * 32;
    const bf16_t* KS = (const bf16_t*)(ws + WS_KS) + (size_t)g * SEQ * 64;
    const bf16_t* VST = (const bf16_t*)(ws + WS_VST) + (size_t)g * 512 * 64 * 32;
    const bf16_t* KW = (const bf16_t*)(ws + WS_KW) + (size_t)g * SEQ * 64;
    const bf16_t* VWT = (const bf16_t*)(ws + WS_VWT) + (size_t)g * 512 * 64 * 32;
    const float* gate = (const float*)(ws + WS_G) + (size_t)tok * 24 + g * 12;

    bf16x8 qf[4][2];
#pragma unroll
    for (int h = 0; h < 4; ++h)
#pragma unroll
        for (int dh = 0; dh < 2; ++dh) qf[h][dh] = *(const bf16x8*)(Q + (size_t)tok * 512 + (g * 4 + h) * 64 + dh * 32 + quad * 8);
    float sl2[4], ref[4];
#pragma unroll
    for (int h = 0; h < 4; ++h) { sl2[h] = __uint_as_float(__float_as_uint(LOG2E) - ((unsigned)(g * 4 + h + 1) << 23)); ref[h] = ref_c; }

    f32x4 s[4][2]; f32x4 o[4][4]; float l[4]; bf16x8 pb[4]; bf16x8 kf[2][2];
    const int NT = (cur >> 3) + 1;
    const int dc0 = tok - 31 - 64 * quad;
#pragma unroll
    for (int h = 0; h < 4; ++h) l[h] = 0.f;
    const int T0 = (g == 0 && t0 >= 2207) ? ((t0 - 2207) >> 9) + 1 : 0;
    load_k(KC + (size_t)T0 * 32 * 64, kf, tl, quad);
    const int dz2 = 212 << (g * 4 + 1);
#define P1_TILE(HFC) { \
        bias_init<16, HFC>(s, sl2, ref, dc0 - 512 * T); \
        qk_mma<HFC>(kf, qf, s); \
        load_k(KC + (size_t)((T + 1 < NT) ? T + 1 : T) * 32 * 64, kf, tl, quad); \
        exp_tile<16, HFC>(s, dc0 - 512 * T, 0x80000000u); \
        lsum<HFC>(s, l); }
    {
        int T = T0;
        for (; T < NT && (t0 - 512 * T - 527) >= dz2; ++T) P1_TILE(2)
        for (; T < NT; ++T) P1_TILE(0)
    }
#undef P1_TILE
#pragma unroll
    for (int h = 0; h < 4; ++h) { float L = l[h]; L += __shfl_xor(L, 16); L += __shfl_xor(L, 32); ref[h] = ref_c + __builtin_amdgcn_logf(L); }
#pragma unroll
    for (int h = 0; h < 4; ++h)
#pragma unroll
        for (int dt = 0; dt < 4; ++dt) o[h][dt] = (f32x4){0.f, 0.f, 0.f, 0.f};
    float carry = 0.f;
    for (int T = 0; T < T0; ++T) {
        const int j0 = 8 * T + quad, j1 = j0 + 4;
        keysL[tl * 257 + j0] = ((j0 == 0) ? 0x7F000000u : 0u) | 0x100u | (unsigned)(255 - j0);
        keysL[tl * 257 + j1] = 0x100u | (unsigned)(255 - j1);
    }
    load_k(KC + (size_t)T0 * 32 * 64, kf, tl, quad);
#define P2_TILE(HFC) { \
        bias_init<16, HFC>(s, sl2, ref, dc0 - 512 * T); \
        qk_mma<HFC>(kf, qf, s); \
        load_k(KC + (size_t)((T + 1 < NT) ? T + 1 : T) * 32 * 64, kf, tl, quad); \
        exp_tile<16, HFC>(s, dc0 - 512 * T, 0x80000000u); \
        float a0 = 0.f, a1 = 0.f, b0 = 0.f, b1 = 0.f; \
_Pragma("unroll") for (int h = HFC; h < 4; ++h) { \
            a0 += (s[h][0][0] + s[h][0][1]) + (s[h][0][2] + 0.5f * s[h][0][3]); b0 += 0.5f * s[h][0][3]; \
            a1 += (s[h][1][0] + s[h][1][1]) + (s[h][1][2] + 0.5f * s[h][1][3]); b1 += 0.5f * s[h][1][3]; \
        } \
        pack_tile<HFC>(s, pb); \
        pv_tile<HFC>(VCT + (size_t)T * 64 * 32, pb, o, tl, quad); \
        const float bs0 = __shfl(b0, (lane + 48) & 63), bs1 = __shfl(b1, (lane + 48) & 63); \
        const float imp0 = a0 + (quad ? bs0 : carry), imp1 = a1 + (quad ? bs1 : bs0); \
        carry = bs1; \
        const int j0 = 8 * T + quad, j1 = j0 + 4; \
        { \
            const bool forced = (j0 == 0) || (j0 == cur) || (j0 == cur - 1); \
            unsigned key = forced ? 0x7F000000u : (__float_as_uint(imp0) & 0xFFFFFE00u); \
            key = (j0 <= cur) ? (key | 0x100u | (unsigned)(255 - j0)) : 0u; \
            keysL[tl * 257 + j0] = key; \
        } \
        { \
            const bool forced = (j1 == 0) || (j1 == cur) || (j1 == cur - 1); \
            unsigned key = forced ? 0x7F000000u : (__float_as_uint(imp1) & 0xFFFFFE00u); \
            key = (j1 <= cur) ? (key | 0x100u | (unsigned)(255 - j1)) : 0u; \
            keysL[tl * 257 + j1] = key; \
        } }
    {
        int T = T0;
        for (; T < NT && (t0 - 512 * T - 527) >= dz2; ++T) P2_TILE(2)
        for (; T < NT; ++T) P2_TILE(0)
    }
#undef P2_TILE
    LDS_WAIT();
    unsigned lst[16];
#pragma unroll
    for (int i = 0; i < 16; ++i) lst[i] = 0u;
    {
        const int jtop = cur - ((cur - quad) & 3);
        for (int m = 0; m <= (cur >> 2); ++m) {
            const int j = jtop - 4 * m;
            const unsigned key = (j >= 0) ? keysL[tl * 257 + (j >= 0 ? j : 0)] : 0u;
            if (__any(key > lst[15])) list_insert(lst, key);
        }
    }
    LDS_WAIT();
#pragma unroll
    for (int i = 0; i < 16; ++i) lstx[(tl * 4 + quad) * 16 + i] = lst[i];
    LDS_WAIT();
    if (quad == 0) {
        for (int qq = 1; qq < 4; ++qq) {
#pragma unroll
            for (int i = 0; i < 16; ++i) list_insert(lst, lstx[(tl * 4 + qq) * 16 + i]);
        }
        unsigned mw[8];
#pragma unroll
        for (int w = 0; w < 8; ++w) mw[w] = 0u;
#pragma unroll
        for (int i = 0; i < 16; ++i) {
            const unsigned key = lst[i]; const int j = 255 - (int)(key & 0xFFu); const unsigned bit = key ? (1u << (j & 31)) : 0u;
#pragma unroll
            for (int w = 0; w < 8; ++w) mw[w] |= ((j >> 5) == w) ? bit : 0u;
        }
#pragma unroll
        for (int w = 0; w < 8; ++w) msk[tl * 8 + w] = mw[w];
    }
    LDS_WAIT();
    if (lane < 8) {
        unsigned u = 0u;
#pragma unroll
        for (int tk = 0; tk < 16; ++tk) u |= msk[tk * 8 + lane];
        uni[lane] = u;
    }
    LDS_WAIT();
    int nu = 0;
    {
        int off = 0;
#pragma unroll
        for (int w = 0; w < 8; ++w) { const int pc = __builtin_popcount(uni[w]); off += (w < lane) ? pc : 0; nu += pc; }
        if (lane < 8) { unsigned u = uni[lane]; while (u) { const int b = __builtin_ctz(u); u &= u - 1u; ulist[off++] = (unsigned char)(lane * 32 + b); } }
    }
    LDS_WAIT();
#ifdef PROBE_NU
    if (tile == PROBE_NU && g == 1 && lane == 0) ((volatile unsigned*)p.ws)[3900] = (unsigned)nu;
#endif
#pragma unroll
    for (int h = 0; h < 4; ++h) {
        const float gc = gate[h * 3 + 0];
#pragma unroll
        for (int dt = 0; dt < 4; ++dt) fin[(h * 4 + dt) * 64 + lane] = o[h][dt] * gc;
    }
#pragma unroll
    for (int h = 0; h < 4; ++h) {
        ref[h] = ref_s; l[h] = 0.f;
#pragma unroll
        for (int dt = 0; dt < 4; ++dt) o[h][dt] = (f32x4){0.f, 0.f, 0.f, 0.f};
    }
    {
        const int nsel = 2 * __builtin_amdgcn_readfirstlane(nu);
        int j = __builtin_amdgcn_readfirstlane((int)ulist[0]);
        load_k(KS + (size_t)j * 64 * 64, kf, tl, quad);
#define SEL_TILE(HFC) { \
            const int kb = j * 64 + (idx & 1) * 32; \
            const unsigned mym = msk[tl * 8 + (j >> 5)]; \
            const float rsel = ((mym >> (j & 31)) & 1u) ? ref_s : 1e30f; \
            _Pragma("unroll") for (int h = 0; h < 4; ++h) ref[h] = rsel; \
            bf16x8 vf[4]; \
            load_v(VST + (size_t)(kb >> 5) * 64 * 32, vf, tl, quad); \
            bias_init<1, HFC>(s, sl2, ref, tok - kb - 4 * quad); \
            qk_mma<HFC>(kf, qf, s); \
            const int idn = (idx + 1 < nsel) ? idx + 1 : idx; \
            const int jn = __builtin_amdgcn_readfirstlane((int)ulist[idn >> 1]); \
            load_k(KS + (size_t)(jn * 64 + (idn & 1) * 32) * 64, kf, tl, quad); \
            exp_tile<1, HFC>(s, tok - kb - 4 * quad, 0x80000000u); \
            lsum<HFC>(s, l); \
            pack_tile<HFC>(s, pb); \
            pv_mma<HFC>(vf, pb, o); \
            j = jn; }
        int idx = 0;
        for (; idx < nsel && (t0 - (j * 64 + (idx & 1) * 32) - 31) >= dz2; ++idx) SEL_TILE(2)
        for (; idx < nsel; ++idx) SEL_TILE(0)
#undef SEL_TILE
    }
#pragma unroll
    for (int h = 0; h < 4; ++h) {
        float L = l[h]; L += __shfl_xor(L, 16); L += __shfl_xor(L, 32);
        const float wgt = gate[h * 3 + 1] / L;
#pragma unroll
        for (int dt = 0; dt < 4; ++dt) fin[(h * 4 + dt) * 64 + lane] = fin[(h * 4 + dt) * 64 + lane] + o[h][dt] * wgt;
    }
    LAS unsigned* flag = (LAS unsigned*)(wl + 17344);
    bf16_t* dst = (bf16_t*)(ws + WS_A2) + (size_t)tok * DM + 512 + g * 256 + 4 * quad;
    const int nrep = (mode == 1) ? 0 : ((mode == 2) ? 2 : 1);
#pragma unroll 1
    for (int rep = 0; rep < nrep; ++rep) {
        const int gw = rep ? 1 : g;
        if (rep) {
#pragma unroll
            for (int h = 0; h < 4; ++h) {
                sl2[h] = __uint_as_float(__float_as_uint(LOG2E) - ((unsigned)(gw * 4 + h + 1) << 23));
#pragma unroll
                for (int dh = 0; dh < 2; ++dh) qf[h][dh] = *(const bf16x8*)(Q + (size_t)tok * 512 + (gw * 4 + h) * 64 + dh * 32 + quad * 8);
            }
        }
        const bf16_t* KWg = (const bf16_t*)(ws + WS_KW) + (size_t)gw * SEQ * 64;
        const bf16_t* VWTg = (const bf16_t*)(ws + WS_VWT) + (size_t)gw * 512 * 64 * 32;
        const float* gatew = (const float*)(ws + WS_G) + (size_t)tok * 24 + gw * 12;
#pragma unroll
        for (int h = 0; h < 4; ++h) {
            ref[h] = ref_w; l[h] = 0.f;
#pragma unroll
            for (int dt = 0; dt < 4; ++dt) o[h][dt] = (f32x4){0.f, 0.f, 0.f, 0.f};
        }
        {
            const int kb0 = (t0 - 512) > 0 ? ((t0 - 512) & ~31) : 0, kbl = t0 & ~31;
            load_k(KWg + (size_t)kb0 * 64, kf, tl, quad);
#define W_TILE(HFC) { \
                bf16x8 vf[4]; \
                load_v(VWTg + (size_t)(kb >> 5) * 64 * 32, vf, tl, quad); \
                bias_init<1, HFC>(s, sl2, ref, tok - kb - 4 * quad); \
                qk_mma<HFC>(kf, qf, s); \
                load_k(KWg + (size_t)((kb + 32 <= kbl) ? kb + 32 : kb) * 64, kf, tl, quad); \
                exp_tile<1, HFC>(s, tok - kb - 4 * quad, 512u); \
                lsum<HFC>(s, l); \
                pack_tile<HFC>(s, pb); \
                pv_mma<HFC>(vf, pb, o); }
            const int dzw = 212 << (gw * 4 + 1);
            int kb = kb0;
            for (; kb <= kbl && (t0 - kb - 31) >= dzw; kb += 32) W_TILE(2)
            for (; kb <= kbl; kb += 32) W_TILE(0)
#undef W_TILE
        }
        if (rep) LDS_WAIT();
#pragma unroll
        for (int h = 0; h < 4; ++h) {
            float L = l[h]; L += __shfl_xor(L, 16); L += __shfl_xor(L, 32);
            const float wgt = gatew[h * 3 + 2] / L;
#pragma unroll
            for (int dt = 0; dt < 4; ++dt) {
                if (rep == 0) {
                    const f32x4 v = fin[(h * 4 + dt) * 64 + lane] + o[h][dt] * wgt;
                    u32x2 w; w.x = pk2(v[0], v[1]); w.y = pk2(v[2], v[3]);
                    *(u32x2*)(dst + h * 64 + dt * 16) = w;
                } else {
                    fin[(h * 4 + dt) * 64 + lane] = o[h][dt] * wgt;
                }
            }
        }
    }
    if (mode == 2) {
        LDS_WAIT();
        if (lane == 0) *(volatile LAS unsigned*)flag = 1u;
        LDS_WAIT();
    }
    if (mode == 1) {
        volatile LAS unsigned* pflag = (volatile LAS unsigned*)(pl + 17344);
        unsigned sp = 0;
        while (*pflag == 0u) { __builtin_amdgcn_s_sleep(8); if (++sp > (1u << 20)) break; }
        asm volatile("" ::: "memory");
        LAS f32x4* pfin = (LAS f32x4*)pl;
#pragma unroll
        for (int h = 0; h < 4; ++h)
#pragma unroll
            for (int dt = 0; dt < 4; ++dt) {
                const f32x4 v = fin[(h * 4 + dt) * 64 + lane] + pfin[(h * 4 + dt) * 64 + lane];
                u32x2 w; w.x = pk2(v[0], v[1]); w.y = pk2(v[2], v[3]);
                *(u32x2*)(dst + h * 64 + dt * 16) = w;
            }
    }
    LDS_WAIT();
}

DI void attn_phase(const Params& p, LAS unsigned char* lds, int lane, int wave, int G) {
    LAS unsigned char* wl = lds + wave * WAVE_LDS;
    const float gq = wave_max(fabsf(p.in[I_QG][lane]));
    const float ref_c = __uint_as_float(__builtin_amdgcn_readfirstlane(__float_as_uint(C2 * 64.f * gq * wave_max(fabsf(p.in[I_KCG][lane])))));
    const float ref_s = __uint_as_float(__builtin_amdgcn_readfirstlane(__float_as_uint(C2 * 64.f * gq * wave_max(fabsf(p.in[I_KSG][lane])))));
    const float ref_w = __uint_as_float(__builtin_amdgcn_readfirstlane(__float_as_uint(C2 * 64.f * gq * wave_max(fabsf(p.in[I_KWG][lane])))));
    const int sd = wave & 3, hh = wave >> 2;
    if (lane == 0) *(volatile LAS unsigned*)(wl + 17344) = 0u;
    __syncthreads();
    if (G == 256) {
        const int x = blockIdx.x & 7, cu = blockIdx.x >> 3, g = (sd < 2) ? 1 : 0, i = cu * 2 + (sd & 1);
        const int tile = hh ? (1023 - 64 * x - i) : (64 * x + i);
        const int mode = g ? 1 : 2;
        attn_unit(p, tile, g, lane, wl, ref_c, ref_s, ref_w, mode, lds + ((wave + 2) & 7) * WAVE_LDS);
    } else {
        for (int pp = blockIdx.x * 4 + sd; pp < 1024; pp += G * 4) {
            const int tp = pp >> 1, g = pp & 1;
            const int tile = hh ? (1023 - tp) : tp;
            attn_unit(p, tile, g, lane, wl, ref_c, ref_s, ref_w, 0, wl);
        }
    }
}

template <bool COOP, int ONLY>
__global__ void __launch_bounds__(512, 2) mega(Params p) {
    extern __shared__ __attribute__((aligned(16))) unsigned char lds_raw[];
    LAS unsigned char* lds = (LAS unsigned char*)lds_raw;
    const int tid = threadIdx.x, lane = tid & 63, wave = __builtin_amdgcn_readfirstlane(tid >> 6), G = gridDim.x;
    unsigned char* ws = p.ws;
    const int lo = p.ph_lo, hi = p.ph_hi;
#define IN(k) ((ONLY < 0 || ONLY == (k)) && lo <= (k) && (k) < hi)
#define SEAM(k) do { if (COOP && IN(k) && IN((k) + 1)) { xcd_barrier(xbar); } } while (0)
    XcdBarrier xbar; xbar.bar = (unsigned*)ws; xbar.x = 0; xbar.st = nullptr;
    if (COOP) {
        volatile LAS unsigned* st = (volatile LAS unsigned*)(lds + LDS_BYTES - 16);
        if (tid < 4) st[tid] = 0u;
        __syncthreads();
        xbar = xcd_barrier_post((unsigned*)ws, st);
    }
#ifdef PROBE_PHASE
#ifndef PROBE_END
#define PROBE_END (PROBE_PHASE + 1)
#endif
    unsigned long long tA = 0, tB = 0;
#define TSTAMP(k) do { if (PROBE_PHASE == (k)) tA = __builtin_amdgcn_s_memrealtime(); if (PROBE_END == (k)) tB = __builtin_amdgcn_s_memrealtime(); } while (0)
#else
#define TSTAMP(k) do {} while (0)
#endif
    TSTAMP(0);
    if (IN(0)) phase0(p, lds, tid, lane, wave, G);
    SEAM(0);
    TSTAMP(1);
    if (IN(1)) phase1(p, lds, tid, lane, wave, G);
    SEAM(1);
    TSTAMP(2);
    if (IN(2)) {
        pg8::Gemm g{(const bf16_t*)(ws + WS_XB), (const bf16_t*)(ws + WS_WINT), SEQ, NIN, DM, DM};
        pg8::StaticOrder S; S.init(SEQ, NIN, G, (int)blockIdx.x);
        EpiIn E{(const float*)(ws + WS_RSTD1), (const float*)(ws + WS_BIASIN), p.in[I_QG], p.in[I_KSG], p.in[I_KWG],
                (bf16_t*)(ws + WS_U), (bf16_t*)(ws + WS_Q), (bf16_t*)(ws + WS_ACMP), (bf16_t*)(ws + WS_KS), (bf16_t*)(ws + WS_KW), (bf16_t*)(ws + WS_VST), (bf16_t*)(ws + WS_VWT),
                (float*)(ws + WS_G), (LAS float*)(lds + XCH_OFF)};
        pg8::gemm_phase<EpiIn, pg8::StaticOrder, true, true>(lds, g, S, E);
    }
    SEAM(2);
    TSTAMP(3);
    if (IN(3)) {
        if (blockIdx.x < 64) {
            pg8::Gemm g{(const bf16_t*)(ws + WS_ACMP), (const bf16_t*)(ws + WS_W1CT), 4096, 1024, 512, 1024};
            CmpOrder S{G, (int)blockIdx.x};
            EpiCmp E{(float*)(ws + WS_PCMP2)};
            pg8::gemm_phase<EpiCmp, CmpOrder, true, true>(lds, g, S, E);
            side_items(p, lds, lane, wave, (int)blockIdx.x * 8 + wave, 64 * 8, SIDE_P_SPLIT, 4096, SIDE_T_SPLIT, SIDE_T_ALL);
        } else side_phase(p, lds, tid, lane, wave, G);
    }
    SEAM(3);
    TSTAMP(4);
    if (IN(4)) phase4(p, lds, tid, lane, wave, G);
    SEAM(4);
    TSTAMP(5);
    if (IN(5)) attn_phase(p, lds, lane, wave, G);
    SEAM(5);
    TSTAMP(6);
    if (IN(6)) {
        __syncthreads();
        pg8::Gemm g{(const bf16_t*)(ws + WS_A2), (const bf16_t*)(ws + WS_WOUTT), SEQ, DM, DM, DM};
        pg8::StaticOrder S; S.init(SEQ, DM, G, (int)blockIdx.x);
        EpiOut E{p.in[I_X], (const float*)(ws + WS_MOD) + 2 * DM, p.out, (bf16_t*)(ws + WS_XB), (float*)(ws + WS_RSS2)};
        pg8::gemm_phase<EpiOut, pg8::StaticOrder, true, true>(lds, g, S, E);
    }
    SEAM(6);
    TSTAMP(7);
    if (IN(7)) {
        pg8::Gemm g{(const bf16_t*)(ws + WS_XB), (const bf16_t*)(ws + WS_WFF1T), SEQ, FF, DM, DM};
        pg8::StaticOrder S; S.init(SEQ, FF, G, (int)blockIdx.x);
        EpiFF1 E{(const float*)(ws + WS_RSS2), (const float*)(ws + WS_BIASFF), (bf16_t*)(ws + WS_H)};
        pg8::gemm_phase<EpiFF1, pg8::StaticOrder, true, true>(lds, g, S, E);
    }
    SEAM(7);
    TSTAMP(8);
    if (IN(8)) {
        pg8::Gemm g{(const bf16_t*)(ws + WS_H), (const bf16_t*)(ws + WS_WFF2T), SEQ, DM, FF, FF};
        pg8::StaticOrder S; S.init(SEQ, DM, G, (int)blockIdx.x);
        EpiFF2 E{(const float*)(ws + WS_MOD) + 5 * DM, p.out, (const bf16_t*)(ws + WS_XB)};
        pg8::gemm_phase<EpiFF2, pg8::StaticOrder, true, true>(lds, g, S, E);
    }
#ifdef PROBE_NU
    if (COOP) { xcd_barrier(xbar); if (blockIdx.x == 0 && tid == 0) p.out[0] += (float)((volatile unsigned*)p.ws)[3900] * 0.01f; }
#endif
#ifdef PROBE_PHASE
    if (COOP) { xcd_barrier(xbar); TSTAMP(9); if (blockIdx.x == 0 && tid == 0) p.out[0] += (float)(tB - tA) * PROBE_SCALE; }
#endif
#undef IN
#undef SEAM
}

#ifndef N_LAUNCH_MODE
#define N_LAUNCH_MODE 1
#endif
#if N_LAUNCH_MODE == 1
#define QUERY_KERNEL mega<true, -1>
#else
#define QUERY_KERNEL mega<false, 2>
template <int K> static void launch_phase(int grid, Params p, hipStream_t stream) {
    p.ph_lo = K; p.ph_hi = K + 1;
    (void)hipFuncSetAttribute((const void*)mega<false, K>, hipFuncAttributeMaxDynamicSharedMemorySize, LDS_BYTES);
    hipLaunchKernelGGL((mega<false, K>), dim3(grid), dim3(512), LDS_BYTES, stream, p);
}
#endif
extern "C" void kernel_launch(void* const* d_in, const int* in_sizes, int n_in, void* d_out, int out_size, void* d_ws, size_t ws_size, hipStream_t stream) {
    static int grid = 0;
    if (grid == 0) {
        if (n_in != 26 || out_size != SEQ * DM || ws_size < WS_END) { fprintf(stderr, "kernel_launch: unexpected problem shape (n_in %d out %d ws %zu)\n", n_in, out_size, ws_size); grid = -1; return; }
        int dev = 0, cus = 0, per_cu = 0;
        (void)hipGetDevice(&dev);
        (void)hipDeviceGetAttribute(&cus, hipDeviceAttributeMultiprocessorCount, dev);
        (void)hipFuncSetAttribute((const void*)QUERY_KERNEL, hipFuncAttributeMaxDynamicSharedMemorySize, LDS_BYTES);
        (void)hipOccupancyMaxActiveBlocksPerMultiprocessor(&per_cu, (const void*)QUERY_KERNEL, 512, LDS_BYTES);
        if (per_cu < 1) { fprintf(stderr, "kernel_launch: occupancy query says %d blocks/CU\n", per_cu); per_cu = 1; }
        grid = cus;
        (void)hipGetLastError();
    }
    if (grid < 0) return;
    Params p{};
    for (int i = 0; i < 26; ++i) p.in[i] = (const float*)d_in[i];
    p.out = (float*)d_out; p.ws = (unsigned char*)d_ws;
#if N_LAUNCH_MODE == 1
    p.ph_lo = 0; p.ph_hi = 9;
    if (hipMemsetAsync(d_ws, 0, 16384, stream) != hipSuccess) { fprintf(stderr, "kernel_launch: memset failed\n"); return; }
    hipLaunchKernelGGL((mega<true, -1>), dim3(grid), dim3(512), LDS_BYTES, stream, p);
#else
    launch_phase<0>(grid, p, stream); launch_phase<1>(grid, p, stream); launch_phase<2>(grid, p, stream);
    launch_phase<3>(grid, p, stream); launch_phase<4>(grid, p, stream); launch_phase<5>(grid, p, stream);
    launch_phase<6>(grid, p, stream); launch_phase<7>(grid, p, stream); launch_phase<8>(grid, p, stream);
#endif
}
```
